# Optimizing an MI355X kernel written in HIP

```python
import math
import jax, jax.numpy as jnp
from jax import lax
import numpy as np

D_MODEL = 1024
BATCH = 2
SEQ = 8192
DEPTH = 2

CHUNK = 64
N_EVEN = (DEPTH + 1) // 2
N_ODD = DEPTH // 2
HEAD_DIM = 64
POOL_WINDOWS = (2, 4, 8, 16)
POOL_GROUPS = 4
POOL_WIDTH = D_MODEL // 2
POOL_GROUP_DIM = POOL_WIDTH // POOL_GROUPS
ATT_HEADS = (D_MODEL // 2) // HEAD_DIM
ATT_WIDTH = ATT_HEADS * HEAD_DIM
LEFT_CHUNKS = 8
BAND = (LEFT_CHUNKS + 1) * CHUNK
REL_CLIP = 128
N_REL = 2 * REL_CLIP + 1
EVEN_IN = POOL_WIDTH + 3 * ATT_WIDTH
EVEN_OUT = POOL_WIDTH + ATT_WIDTH
SSM_WIDTH = D_MODEL // 2
SSM_GROUP_DIM = 16
SSM_GROUPS = SSM_WIDTH // SSM_GROUP_DIM
SSM_STATE = 64
DT_MIN = 1e-3
DT_MAX = 1e-1
FOX_HEADS = (D_MODEL // 2) // HEAD_DIM
FOX_WIDTH = FOX_HEADS * HEAD_DIM
ODD_IN = SSM_WIDTH + 3 * FOX_WIDTH + FOX_HEADS
ODD_OUT = SSM_WIDTH + FOX_WIDTH
Q_BLOCK = 128
N_EXPERTS = 32
TOP_K = 4
D_EXPERT = D_MODEL
SWIGLU_LIMIT = 7.0
SWIGLU_ALPHA = 1.702
ROW_BLOCK = 128
DN_ALPHA = (2.0 * DEPTH) ** 0.25
DN_BETA = (8.0 * DEPTH) ** -0.25
LN_EPS = 1e-5
NEG_INF = -1e30

kernel_name = "hybrid_pool_chunkattn_s5_fox_moe"


def layer_norm(x, g, b):
    xf = x.astype(jnp.float32)
    mu = jnp.mean(xf, axis=-1, keepdims=True)
    var = jnp.mean(jnp.square(xf - mu), axis=-1, keepdims=True)
    return ((xf - mu) * lax.rsqrt(var + LN_EPS) * g.astype(jnp.float32) + b.astype(jnp.float32)).astype(x.dtype)


def ada_mod(c, w, b):
    m = jax.nn.silu(c) @ w + b
    shift, scale, gate = jnp.split(m[:, None, :], 3, axis=-1)
    return shift, scale, gate


def pool_mixer(u, w_pool, pool_scale):
    Bn, S, _ = u.shape
    ug = u.reshape(Bn, S, POOL_GROUPS, POOL_GROUP_DIM).astype(jnp.float32)
    cs = jnp.concatenate([jnp.zeros_like(ug[:, :1]), jnp.cumsum(ug, axis=1)], axis=1)
    t = jnp.arange(S)[:, None]
    win = jnp.array(POOL_WINDOWS, dtype=jnp.int32)[None, :]
    lo = jnp.maximum(t + 1 - win, 0)
    cnt = (t + 1 - lo).astype(jnp.float32)[None, :, :, None]
    window_sum = cs[:, 1:] - cs[:, lo, jnp.arange(POOL_GROUPS)[None, :]]
    d = (window_sum / cnt - ug).astype(u.dtype)
    y = jnp.einsum('bsgc,gcd->bsgd', d, w_pool)
    return y.reshape(Bn, S, POOL_WIDTH) * pool_scale


def chunk_attention(q, k, v, rel_bias):
    Bn, S, H, Dh = q.shape
    nc = S // CHUNK
    qc = q.reshape(Bn, nc, CHUNK, H, Dh)

    def band(t):
        tp = jnp.pad(t.reshape(Bn, nc, CHUNK, H, Dh), ((0, 0), (LEFT_CHUNKS, 0), (0, 0), (0, 0), (0, 0)))
        return jnp.concatenate([tp[:, j:j + nc] for j in range(LEFT_CHUNKS + 1)], axis=2)

    kb, vb = band(k), band(v)
    scores = jnp.einsum('bnqhd,bnkhd->bnhqk', qc, kb).astype(jnp.float32) * (Dh ** -0.5)
    q_pos = jnp.arange(CHUNK)[:, None]
    k_pos = jnp.arange(BAND)[None, :] - LEFT_CHUNKS * CHUNK
    rel = jnp.clip(q_pos - k_pos, -REL_CLIP, REL_CLIP) + REL_CLIP
    bias = rel_bias.astype(jnp.float32)[:, rel]
    key_chunk = jnp.arange(nc)[:, None] - LEFT_CHUNKS + jnp.arange(BAND)[None, :] // CHUNK
    scores = jnp.where((key_chunk >= 0)[None, :, None, None, :], scores + bias[None, None], NEG_INF)
    p = jax.nn.softmax(scores, axis=-1).astype(v.dtype)
    o = jnp.einsum('bnhqk,bnkhd->bnqhd', p, vb)
    return o.reshape(Bn, S, H * Dh)


def s5_mixer(u, lam_re, lam_im, log_dt, b_re, b_im, c_re, c_im, d_skip, glu_w, glu_b):
    Bn, S, _ = u.shape
    ug = u.reshape(Bn, S, SSM_GROUPS, SSM_GROUP_DIM).astype(jnp.float32)
    dt = jnp.exp(log_dt.astype(jnp.float32))[:, None]
    lre = jnp.minimum(lam_re.astype(jnp.float32), -1e-4)
    lim = lam_im.astype(jnp.float32)
    mag = jnp.exp(lre * dt)
    abar_re, abar_im = mag * jnp.cos(lim * dt), mag * jnp.sin(lim * dt)
    den = lre * lre + lim * lim
    nre, nim = abar_re - 1.0, abar_im
    g_re = (nre * lre + nim * lim) / den
    g_im = (nim * lre - nre * lim) / den
    bre, bim = b_re.astype(jnp.float32), b_im.astype(jnp.float32)
    bb_re = g_re[..., None] * bre - g_im[..., None] * bim
    bb_im = g_re[..., None] * bim + g_im[..., None] * bre
    bu_re = jnp.einsum('bsgc,gpc->bsgp', ug, bb_re)
    bu_im = jnp.einsum('bsgc,gpc->bsgp', ug, bb_im)
    a_re = jnp.broadcast_to(abar_re, bu_re.shape)
    a_im = jnp.broadcast_to(abar_im, bu_im.shape)

    def combine(e1, e2):
        a1r, a1i, b1r, b1i = e1
        a2r, a2i, b2r, b2i = e2
        return (a2r * a1r - a2i * a1i,
                a2r * a1i + a2i * a1r,
                a2r * b1r - a2i * b1i + b2r,
                a2r * b1i + a2i * b1r + b2i)

    _, _, xr, xi = lax.associative_scan(combine, (a_re, a_im, bu_re, bu_im), axis=1)
    y = (jnp.einsum('bsgp,gcp->bsgc', xr, c_re.astype(jnp.float32))
         - jnp.einsum('bsgp,gcp->bsgc', xi, c_im.astype(jnp.float32))
         + d_skip.astype(jnp.float32) * ug)
    y = jax.nn.gelu(y.reshape(Bn, S, SSM_WIDTH))
    y = y * jax.nn.sigmoid(y @ glu_w.astype(jnp.float32) + glu_b.astype(jnp.float32))
    return y.astype(u.dtype)


def forgetting_attention(q, k, v, f_logit):
    Bn, S, H, Dh = q.shape
    F = jnp.cumsum(jax.nn.log_sigmoid(f_logit.astype(jnp.float32)), axis=1)
    Fh = jnp.transpose(F, (0, 2, 1))
    k_pos = jnp.arange(S)
    q_off = jnp.arange(Q_BLOCK)

    def block(i):
        q0 = i * Q_BLOCK
        qb = lax.dynamic_slice_in_dim(q, q0, Q_BLOCK, axis=1)
        fq = lax.dynamic_slice_in_dim(Fh, q0, Q_BLOCK, axis=2)
        s = jnp.einsum('bqhd,bkhd->bhqk', qb, k).astype(jnp.float32) * (Dh ** -0.5)
        s = s + fq[..., None] - Fh[:, :, None, :]
        s = jnp.where(k_pos[None, :] <= (q0 + q_off)[:, None], s, NEG_INF)
        p = jax.nn.softmax(s, axis=-1).astype(v.dtype)
        return jnp.einsum('bhqk,bkhd->bqhd', p, v)

    o = lax.map(block, jnp.arange(S // Q_BLOCK))
    return jnp.transpose(o, (1, 0, 2, 3, 4)).reshape(Bn, S, H * Dh)


def even_mixer(h, w_in, w_pool, pool_scale, rel_bias, w_out):
    Bn, S, _ = h.shape
    z = h @ w_in
    o1, o2, o3 = POOL_WIDTH, POOL_WIDTH + ATT_WIDTH, POOL_WIDTH + 2 * ATT_WIDTH
    heads = lambda t: t.reshape(Bn, S, ATT_HEADS, HEAD_DIM)
    ya = pool_mixer(z[..., :o1], w_pool, pool_scale)
    yb = chunk_attention(heads(z[..., o1:o2]), heads(z[..., o2:o3]), heads(z[..., o3:]), rel_bias)
    return jnp.concatenate([ya, yb], axis=-1) @ w_out


def odd_mixer(h, w_in, forget_b, lam_re, lam_im, log_dt, b_re, b_im, c_re, c_im, d_skip, glu_w, glu_b, w_out):
    Bn, S, _ = h.shape
    z = h @ w_in
    o1 = SSM_WIDTH
    o2, o3, o4 = o1 + FOX_WIDTH, o1 + 2 * FOX_WIDTH, o1 + 3 * FOX_WIDTH
    heads = lambda t: t.reshape(Bn, S, FOX_HEADS, HEAD_DIM)
    yc = s5_mixer(z[..., :o1], lam_re, lam_im, log_dt, b_re, b_im, c_re, c_im, d_skip, glu_w, glu_b)
    yd = forgetting_attention(heads(z[..., o1:o2]), heads(z[..., o2:o3]), heads(z[..., o3:o4]),
                              z[..., o4:] + forget_b)
    return jnp.concatenate([yc, yd], axis=-1) @ w_out


def moe_ffn(h, router_w, router_b, w_gu, b_gu, w_down, b_down):
    Bn, S, D = h.shape
    xt = h.reshape(-1, D)
    T = xt.shape[0]
    logits = (xt @ router_w + router_b).astype(jnp.float32)
    top_v, top_e = lax.top_k(logits, TOP_K)
    gates = jax.nn.softmax(top_v, axis=-1)
    e_flat = top_e.reshape(-1)
    tok_flat = jnp.arange(T * TOP_K) // TOP_K
    order = jnp.argsort(e_flat)
    e_sorted, tok_sorted = e_flat[order], tok_flat[order]
    g_sorted = gates.reshape(-1)[order].astype(h.dtype)
    counts = jnp.zeros((N_EXPERTS,), jnp.int32).at[e_flat].add(1)
    padded = (counts + ROW_BLOCK - 1) // ROW_BLOCK * ROW_BLOCK
    start = jnp.cumsum(counts) - counts
    pend = jnp.cumsum(padded)
    pstart = pend - padded
    dest = pstart[e_sorted] + (jnp.arange(T * TOP_K) - start[e_sorted])
    n_blocks = (T * TOP_K + N_EXPERTS * (ROW_BLOCK - 1) + ROW_BLOCK - 1) // ROW_BLOCK
    n_rows = n_blocks * ROW_BLOCK
    x_disp = jnp.zeros((n_rows, D), h.dtype).at[dest].set(xt[tok_sorted])
    blk_expert = jnp.minimum(jnp.searchsorted(pend, jnp.arange(n_blocks) * ROW_BLOCK, side='right'), N_EXPERTS - 1)

    def expert_block(args):
        xb, e = args
        gu = xb @ w_gu[e] + b_gu[e]
        gate = jnp.minimum(gu[:, :D_EXPERT], SWIGLU_LIMIT)
        up = jnp.clip(gu[:, D_EXPERT:], -SWIGLU_LIMIT, SWIGLU_LIMIT)
        glu = gate * jax.nn.sigmoid(SWIGLU_ALPHA * gate)
        return ((up + 1.0) * glu) @ w_down[e] + b_down[e]

    y_disp = lax.map(expert_block, (x_disp.reshape(n_blocks, ROW_BLOCK, D), blk_expert)).reshape(n_rows, D)
    y = jnp.zeros((T, D), h.dtype).at[tok_sorted].add(y_disp[dest] * g_sorted[:, None])
    return y.reshape(Bn, S, D)


def setup_inputs(seed: int = 0) -> dict:
    key = jax.random.key(seed)
    ks = jax.random.split(key, 30)
    nrm = lambda k, shape, s: jax.random.normal(k, shape, jnp.float32) * s
    D = D_MODEL
    return {
        "x": nrm(ks[0], (BATCH, SEQ, D), 1.0),
        "c": nrm(ks[1], (BATCH, D), 1.0),
        "mod_w": nrm(ks[2], (DEPTH, 2, D, 3 * D), 0.3 * D ** -0.5),
        "mod_b": nrm(ks[3], (DEPTH, 2, 3 * D), 0.02),
        "ln_g": 1.0 + nrm(ks[4], (DEPTH, 2, D), 0.02),
        "ln_b": nrm(ks[5], (DEPTH, 2, D), 0.02),
        "even_w_in": nrm(ks[6], (N_EVEN, D, EVEN_IN), D ** -0.5),
        "pool_w": nrm(ks[7], (N_EVEN, POOL_GROUPS, POOL_GROUP_DIM, POOL_GROUP_DIM), POOL_GROUP_DIM ** -0.5),
        "pool_scale": 1.0 + nrm(ks[8], (N_EVEN, POOL_WIDTH), 0.02),
        "rel_bias": nrm(ks[9], (N_EVEN, ATT_HEADS, N_REL), 0.5),
        "even_w_out": nrm(ks[10], (N_EVEN, EVEN_OUT, D), DN_BETA * EVEN_OUT ** -0.5),
        "odd_w_in": nrm(ks[11], (N_ODD, D, ODD_IN), D ** -0.5),
        "forget_b": jax.random.uniform(ks[12], (N_ODD, FOX_HEADS), jnp.float32, 1.0, 4.0),
        "ssm_lam_re": -0.5 + nrm(ks[13], (N_ODD, SSM_GROUPS, SSM_STATE), 0.01),
        "ssm_lam_im": math.pi * jnp.arange(SSM_STATE, dtype=jnp.float32) + nrm(ks[14], (N_ODD, SSM_GROUPS, SSM_STATE), 0.01),
        "ssm_log_dt": jax.random.uniform(ks[15], (N_ODD, SSM_GROUPS), jnp.float32, math.log(DT_MIN), math.log(DT_MAX)),
        "ssm_b_re": nrm(ks[16], (N_ODD, SSM_GROUPS, SSM_STATE, SSM_GROUP_DIM), (2 * SSM_GROUP_DIM) ** -0.5),
        "ssm_b_im": nrm(ks[17], (N_ODD, SSM_GROUPS, SSM_STATE, SSM_GROUP_DIM), (2 * SSM_GROUP_DIM) ** -0.5),
        "ssm_c_re": nrm(ks[18], (N_ODD, SSM_GROUPS, SSM_GROUP_DIM, SSM_STATE), SSM_STATE ** -0.5),
        "ssm_c_im": nrm(ks[19], (N_ODD, SSM_GROUPS, SSM_GROUP_DIM, SSM_STATE), SSM_STATE ** -0.5),
        "ssm_d": nrm(ks[20], (N_ODD, SSM_GROUPS, SSM_GROUP_DIM), 1.0),
        "ssm_glu_w": nrm(ks[21], (N_ODD, SSM_WIDTH, SSM_WIDTH), SSM_WIDTH ** -0.5),
        "ssm_glu_b": nrm(ks[22], (N_ODD, SSM_WIDTH), 0.02),
        "odd_w_out": nrm(ks[23], (N_ODD, ODD_OUT, D), DN_BETA * ODD_OUT ** -0.5),
        "router_w": nrm(ks[24], (DEPTH, D, N_EXPERTS), D ** -0.5),
        "router_b": nrm(ks[25], (DEPTH, N_EXPERTS), 0.01),
        "exp_w_gu": nrm(ks[26], (DEPTH, N_EXPERTS, D, 2 * D_EXPERT), D ** -0.5),
        "exp_b_gu": nrm(ks[27], (DEPTH, N_EXPERTS, 2 * D_EXPERT), 0.02),
        "exp_w_down": nrm(ks[28], (DEPTH, N_EXPERTS, D_EXPERT, D), DN_BETA * D_EXPERT ** -0.5),
        "exp_b_down": nrm(ks[29], (DEPTH, N_EXPERTS, D), 0.02),
    }


def reference(x, c, mod_w, mod_b, ln_g, ln_b, even_w_in, pool_w, pool_scale, rel_bias, even_w_out,
              odd_w_in, forget_b, ssm_lam_re, ssm_lam_im, ssm_log_dt, ssm_b_re, ssm_b_im, ssm_c_re, ssm_c_im,
              ssm_d, ssm_glu_w, ssm_glu_b, odd_w_out, router_w, router_b, exp_w_gu, exp_b_gu, exp_w_down,
              exp_b_down):
    for layer in range(DEPTH):
        i = layer // 2
        shift, scale, gate = ada_mod(c, mod_w[layer, 0], mod_b[layer, 0])
        h = x * (1.0 + scale) + shift
        if layer % 2 == 0:
            y = even_mixer(h, even_w_in[i], pool_w[i], pool_scale[i], rel_bias[i], even_w_out[i])
        else:
            y = odd_mixer(h, odd_w_in[i], forget_b[i], ssm_lam_re[i], ssm_lam_im[i], ssm_log_dt[i],
                          ssm_b_re[i], ssm_b_im[i], ssm_c_re[i], ssm_c_im[i], ssm_d[i], ssm_glu_w[i],
                          ssm_glu_b[i], odd_w_out[i])
        x = layer_norm(DN_ALPHA * x + (1.0 + gate) * y, ln_g[layer, 0], ln_b[layer, 0])
        shift, scale, gate = ada_mod(c, mod_w[layer, 1], mod_b[layer, 1])
        h = x * (1.0 + scale) + shift
        y = moe_ffn(h, router_w[layer], router_b[layer], exp_w_gu[layer], exp_b_gu[layer],
                    exp_w_down[layer], exp_b_down[layer])
        x = layer_norm(DN_ALPHA * x + (1.0 + gate) * y, ln_g[layer, 1], ln_b[layer, 1])
    return x
```

```cpp
#include <hip/hip_runtime.h>
#include <cstdio>
#include <cstring>
#include <cmath>
namespace nv {
constexpr int T = 16384, S = 8192, D = 1024, NB = 2;
constexpr int MAXROWS = 73728;
constexpr float DN_ALPHA = 1.41421356237309515f;
constexpr float LN_EPS = 1e-5f;

__global__ void k_mod(const float* __restrict__ c, const float* __restrict__ mod_w, const float* __restrict__ mod_b, float* __restrict__ modv) {
    int idx = blockIdx.x * blockDim.x + threadIdx.x;
    if (idx >= 4 * 3072) return;
    int lj = idx / 3072, n = idx % 3072;
    const float* w = mod_w + (size_t)lj * 1024 * 3072;
    float a0 = 0.f, a1 = 0.f;
    for (int k = 0; k < 1024; ++k) {
        float c0 = c[k], c1 = c[1024 + k];
        float s0 = c0 / (1.f + expf(-c0)), s1 = c1 / (1.f + expf(-c1));
        float wv = w[(size_t)k * 3072 + n];
        a0 += s0 * wv; a1 += s1 * wv;
    }
    float bb = mod_b[lj * 3072 + n];
    modv[(lj * 2 + 0) * 3072 + n] = a0 + bb;
    modv[(lj * 2 + 1) * 3072 + n] = a1 + bb;
}

__global__ void k_modulate(const float* __restrict__ x, const float* __restrict__ modv_lj, float* __restrict__ h) {
    size_t idx = (size_t)blockIdx.x * blockDim.x + threadIdx.x;
    if (idx >= (size_t)T * D) return;
    int t = (int)(idx / D), d = (int)(idx % D), b = t / S;
    const float* m = modv_lj + b * 3072;
    h[idx] = x[idx] * (1.f + m[1024 + d]) + m[d];
}

struct GemmArgs {
    const float* A; int lda; const float* B; int ldb; const float* bias; const float* colscale; float* C; int ldc; int M, N, K;
    const int* pstart; size_t strideB; int strideBias;
};
__device__ __forceinline__ int expert_of_row(const int* pstart, int row) { int e = 0; for (int i = 1; i < 32; ++i) if (row >= pstart[i]) e = i; return e; }

__global__ void __launch_bounds__(256) k_gemm(GemmArgs g) {
    __shared__ float As[16][65]; __shared__ float Bs[16][64];
    const int row0 = blockIdx.y * 64, col0 = blockIdx.x * 64;
    const float* B = g.B; const float* bias = g.bias; int M = g.M;
    if (g.pstart) { M = g.pstart[32]; if (row0 >= M) return; int e = expert_of_row(g.pstart, row0); B += (size_t)e * g.strideB; if (bias) bias += (size_t)e * g.strideBias; }
    if (row0 >= M) return;
    const int tid = threadIdx.x, tx = tid % 16, ty = tid / 16;
    float acc[4][4] = {};
    for (int k0 = 0; k0 < g.K; k0 += 16) {
        for (int i = tid; i < 64 * 16; i += 256) { int r = i / 16, k = i % 16; int row = row0 + r; As[k][r] = (row < M) ? g.A[(size_t)row * g.lda + k0 + k] : 0.f; }
        for (int i = tid; i < 16 * 64; i += 256) { int k = i / 64, c = i % 64; int col = col0 + c; Bs[k][c] = (col < g.N) ? B[(size_t)(k0 + k) * g.ldb + col] : 0.f; }
        __syncthreads();
#pragma unroll
        for (int k = 0; k < 16; ++k) {
            float a[4], b[4];
#pragma unroll
            for (int i = 0; i < 4; ++i) { a[i] = As[k][ty * 4 + i]; b[i] = Bs[k][tx * 4 + i]; }
#pragma unroll
            for (int i = 0; i < 4; ++i)
#pragma unroll
                for (int j = 0; j < 4; ++j) acc[i][j] += a[i] * b[j];
        }
        __syncthreads();
    }
    for (int i = 0; i < 4; ++i) for (int j = 0; j < 4; ++j) {
        int row = row0 + ty * 4 + i, col = col0 + tx * 4 + j;
        if (row < M && col < g.N) { float v = acc[i][j]; if (bias) v += bias[col]; if (g.colscale) v *= g.colscale[col]; g.C[(size_t)row * g.ldc + col] = v; }
    }
}

__global__ void __launch_bounds__(256) k_moe1(const float* __restrict__ H, const int* __restrict__ tok_of_slot, const int* __restrict__ pstart,
                                              const float* __restrict__ Wgu, const float* __restrict__ Bgu, float* __restrict__ ACT) {
    __shared__ float As[16][65]; __shared__ float Bg[16][64]; __shared__ float Bu[16][64]; __shared__ int toks[64];
    const int row0 = blockIdx.y * 64, col0 = blockIdx.x * 64;
    const int M = pstart[32]; if (row0 >= M) return;
    const int e = expert_of_row(pstart, row0);
    const float* B = Wgu + (size_t)e * 1024 * 2048; const float* bias = Bgu + (size_t)e * 2048;
    const int tid = threadIdx.x, tx = tid % 16, ty = tid / 16;
    if (tid < 64) toks[tid] = tok_of_slot[row0 + tid];
    __syncthreads();
    float ag[4][4] = {}, au[4][4] = {};
    for (int k0 = 0; k0 < 1024; k0 += 16) {
        for (int i = tid; i < 64 * 16; i += 256) { int r = i / 16, k = i % 16; As[k][r] = H[(size_t)toks[r] * 1024 + k0 + k]; }
        for (int i = tid; i < 16 * 64; i += 256) { int k = i / 64, c = i % 64; Bg[k][c] = B[(size_t)(k0 + k) * 2048 + col0 + c]; Bu[k][c] = B[(size_t)(k0 + k) * 2048 + 1024 + col0 + c]; }
        __syncthreads();
#pragma unroll
        for (int k = 0; k < 16; ++k) {
            float a[4], bg[4], bu[4];
#pragma unroll
            for (int i = 0; i < 4; ++i) { a[i] = As[k][ty * 4 + i]; bg[i] = Bg[k][tx * 4 + i]; bu[i] = Bu[k][tx * 4 + i]; }
#pragma unroll
            for (int i = 0; i < 4; ++i)
#pragma unroll
                for (int j = 0; j < 4; ++j) { ag[i][j] += a[i] * bg[j]; au[i][j] += a[i] * bu[j]; }
        }
        __syncthreads();
    }
    for (int i = 0; i < 4; ++i) for (int j = 0; j < 4; ++j) {
        int row = row0 + ty * 4 + i, col = col0 + tx * 4 + j;
        float gate = fminf(ag[i][j] + bias[col], 7.0f);
        float up = fminf(fmaxf(au[i][j] + bias[1024 + col], -7.0f), 7.0f);
        float glu = gate / (1.f + expf(-1.702f * gate));
        ACT[(size_t)row * 1024 + col] = (up + 1.0f) * glu;
    }
}

__global__ void k_pool(const float* __restrict__ Z, int ldz, float* __restrict__ Dp) {
    size_t idx = (size_t)blockIdx.x * blockDim.x + threadIdx.x;
    if (idx >= (size_t)T * 512) return;
    int t = (int)(idx / 512), col = (int)(idx % 512), g = col / 128;
    int s = t % S; int win = 2 << g; int lo = s + 1 - win; if (lo < 0) lo = 0; int cnt = s + 1 - lo;
    float sum = 0.f;
    for (int i = lo; i <= s; ++i) sum += Z[(size_t)(t - s + i) * ldz + col];
    Dp[idx] = sum / (float)cnt - Z[(size_t)t * ldz + col];
}

__global__ void __launch_bounds__(64) k_chunk_attn(const float* __restrict__ Z, int ldz, const float* __restrict__ rel_bias, float* __restrict__ CAT) {
    int gid = blockIdx.x * 64 + threadIdx.x;
    int s = gid % S, h = (gid / S) % 8, b = gid / (S * 8);
    int t = b * S + s, chunk = s / 64, qpos = s % 64;
    float q[64], o[64];
    const float* qp = Z + (size_t)t * ldz + 512 + h * 64;

_Pragma("unroll") for (int d = 0; d < 64; ++d) { q[d] = qp[d]; o[d] = 0.f; }
    float m = -1e30f, l = 0.f;
    for (int j = 0; j < 9; ++j) {
        int kc = chunk - 8 + j; if (kc < 0) continue;
        for (int kk = 0; kk < 64; ++kk) {
            int ks = kc * 64 + kk, kt = b * S + ks;
            const float* kp = Z + (size_t)kt * ldz + 1024 + h * 64;
            const float* vp = Z + (size_t)kt * ldz + 1536 + h * 64;
            float dot = 0.f;

_Pragma("unroll") for (int d = 0; d < 64; ++d) dot += q[d] * kp[d];
            int kpos = (j - 8) * 64 + kk; int rel = qpos - kpos; rel = rel < -128 ? -128 : (rel > 128 ? 128 : rel); rel += 128;
            float sc = dot * 0.125f + rel_bias[h * 257 + rel];
            float mn = fmaxf(m, sc); float al = expf(m - mn), p = expf(sc - mn);
            l = l * al + p;

_Pragma("unroll") for (int d = 0; d < 64; ++d) o[d] = o[d] * al + p * vp[d];
            m = mn;
        }
    }
    float inv = 1.f / l;
    float* op = CAT + (size_t)t * 1024 + 512 + h * 64;

_Pragma("unroll") for (int d = 0; d < 64; ++d) op[d] = o[d] * inv;
}

__global__ void __launch_bounds__(256) k_ln(const float* __restrict__ x, const float* __restrict__ y, const float* __restrict__ modv_lj, const float* __restrict__ lg, const float* __restrict__ lb, float* __restrict__ out) {
    int row = blockIdx.x * 4 + threadIdx.x / 64, lane = threadIdx.x % 64;
    if (row >= T) return;
    int b = row / S; const float* gate = modv_lj + b * 3072 + 2048;
    float v[16]; float sum = 0.f;

_Pragma("unroll") for (int i = 0; i < 16; ++i) { int d = lane + i * 64; v[i] = DN_ALPHA * x[(size_t)row * D + d] + (1.f + gate[d]) * y[(size_t)row * D + d]; sum += v[i]; }

_Pragma("unroll") for (int o = 32; o > 0; o >>= 1) sum += __shfl_xor(sum, o);
    float mu = sum / 1024.f, q = 0.f;

_Pragma("unroll") for (int i = 0; i < 16; ++i) { float dd = v[i] - mu; q += dd * dd; }

_Pragma("unroll") for (int o = 32; o > 0; o >>= 1) q += __shfl_xor(q, o);
    float rstd = rsqrtf(q / 1024.f + LN_EPS);

_Pragma("unroll") for (int i = 0; i < 16; ++i) { int d = lane + i * 64; out[(size_t)row * D + d] = (v[i] - mu) * rstd * lg[d] + lb[d]; }
}

__global__ void k_route(const float* __restrict__ logits, int* __restrict__ count, int* __restrict__ top_e, float* __restrict__ gates, int* __restrict__ pos) {
    int t = blockIdx.x * blockDim.x + threadIdx.x; if (t >= T) return;
    float v[32];
#pragma unroll
    for (int i = 0; i < 32; ++i) v[i] = logits[(size_t)t * 32 + i];
    int e[4]; float tv[4]; unsigned taken = 0u;
#pragma unroll
    for (int k = 0; k < 4; ++k) { int bi = 0; float bv = -INFINITY;
#pragma unroll
        for (int i = 0; i < 32; ++i) { bool ok = !((taken >> i) & 1u) && (v[i] > bv); bv = ok ? v[i] : bv; bi = ok ? i : bi; }
        e[k] = bi; tv[k] = bv; taken |= 1u << bi; }
    float mx = tv[0]; float ex[4], sum = 0.f;
#pragma unroll
    for (int k = 0; k < 4; ++k) { ex[k] = expf(tv[k] - mx); sum += ex[k]; }
#pragma unroll
    for (int k = 0; k < 4; ++k) { top_e[t * 4 + k] = e[k]; gates[t * 4 + k] = ex[k] / sum; pos[t * 4 + k] = atomicAdd(&count[e[k]], 1); }
}
__global__ void k_offsets(const int* __restrict__ count, int* __restrict__ pstart) {
    if (threadIdx.x == 0 && blockIdx.x == 0) { int acc = 0; for (int e = 0; e < 32; ++e) { pstart[e] = acc; acc += (count[e] + 255) / 256 * 256; } pstart[32] = acc; }
}
__global__ void k_fill(const int* __restrict__ top_e, const int* __restrict__ pos, const int* __restrict__ pstart, int* __restrict__ tok_of_slot, int* __restrict__ slot_of_pair) {
    int i = blockIdx.x * blockDim.x + threadIdx.x; if (i >= T * 4) return;
    int slot = pstart[top_e[i]] + pos[i]; tok_of_slot[slot] = i / 4; slot_of_pair[i] = slot;
}
__global__ void k_combine(const float* __restrict__ YP, const int* __restrict__ slot_of_pair, const float* __restrict__ gates, float* __restrict__ Y) {
    size_t idx = (size_t)blockIdx.x * blockDim.x + threadIdx.x; if (idx >= (size_t)T * D) return;
    int t = (int)(idx / D), d = (int)(idx % D); float acc = 0.f;
    for (int k = 0; k < 4; ++k) acc += YP[(size_t)slot_of_pair[t * 4 + k] * D + d] * gates[t * 4 + k];
    Y[idx] = acc;
}

__global__ void __launch_bounds__(64) k_s5(const float* __restrict__ Z, int ldz, const float* __restrict__ lam_re, const float* __restrict__ lam_im, const float* __restrict__ log_dt,
                                           const float* __restrict__ b_re, const float* __restrict__ b_im, const float* __restrict__ c_re, const float* __restrict__ c_im, const float* __restrict__ d_skip,
                                           float* __restrict__ YG) {
    int b = blockIdx.x / 32, g = blockIdx.x % 32, p = threadIdx.x;
    float dt = expf(log_dt[g]);
    float lre = fminf(lam_re[g * 64 + p], -1e-4f), lim = lam_im[g * 64 + p];
    float mag = expf(lre * dt); float ar = mag * cosf(lim * dt), ai = mag * sinf(lim * dt);
    float den = lre * lre + lim * lim, nre = ar - 1.f, nim = ai;
    float gre = (nre * lre + nim * lim) / den, gim = (nim * lre - nre * lim) / den;
    float bbr[16], bbi[16], cr[16], ci[16];

_Pragma("unroll") for (int c = 0; c < 16; ++c) {
        float br = b_re[(g * 64 + p) * 16 + c], bi = b_im[(g * 64 + p) * 16 + c];
        bbr[c] = gre * br - gim * bi; bbi[c] = gre * bi + gim * br;
        cr[c] = c_re[(g * 16 + c) * 64 + p]; ci[c] = c_im[(g * 16 + c) * 64 + p];
    }
    float xr = 0.f, xi = 0.f;
    for (int s = 0; s < S; ++s) {
        const float* up = Z + (size_t)(b * S + s) * ldz + g * 16;
        float u[16]; float bur = 0.f, bui = 0.f;

_Pragma("unroll") for (int c = 0; c < 16; ++c) { u[c] = up[c]; bur += bbr[c] * u[c]; bui += bbi[c] * u[c]; }
        float nxr = ar * xr - ai * xi + bur, nxi = ar * xi + ai * xr + bui; xr = nxr; xi = nxi;
        float myout = 0.f;

_Pragma("unroll") for (int c = 0; c < 16; ++c) {
            float v = cr[c] * xr - ci[c] * xi;

_Pragma("unroll") for (int o = 32; o > 0; o >>= 1) v += __shfl_xor(v, o);
            if (p == c) myout = v + d_skip[g * 16 + c] * u[c];
        }
        if (p < 16) {
            float y = myout;
            float gl = 0.5f * y * (1.f + tanhf(0.7978845608028654f * (y + 0.044715f * y * y * y)));
            YG[(size_t)(b * S + s) * 512 + g * 16 + p] = gl;
        }
    }
}
__global__ void k_glu(const float* __restrict__ YG, const float* __restrict__ GL, float* __restrict__ CAT) {
    size_t idx = (size_t)blockIdx.x * blockDim.x + threadIdx.x; if (idx >= (size_t)T * 512) return;
    int t = (int)(idx / 512), c = (int)(idx % 512);
    float y = YG[idx], gl = GL[idx];
    CAT[(size_t)t * 1024 + c] = y / (1.f + expf(-gl));
}
__global__ void k_fcum(const float* __restrict__ Z, int ldz, const float* __restrict__ forget_b, float* __restrict__ F) {
    int i = blockIdx.x * blockDim.x + threadIdx.x; if (i >= 16) return;
    int b = i / 8, h = i % 8; float acc = 0.f; float fb = forget_b[h];
    for (int s = 0; s < S; ++s) { float x = Z[(size_t)(b * S + s) * ldz + 2048 + h] + fb; float ls = fminf(x, 0.f) - log1pf(expf(-fabsf(x))); acc += ls; F[(size_t)(b * 8 + h) * S + s] = acc; }
}
__global__ void __launch_bounds__(64) k_fox(const float* __restrict__ Z, int ldz, const float* __restrict__ F, float* __restrict__ CAT) {
    int gid = blockIdx.x * 64 + threadIdx.x;
    int s = gid % S, h = (gid / S) % 8, b = gid / (S * 8);
    int t = b * S + s;
    float q[64], o[64];
    const float* qp = Z + (size_t)t * ldz + 512 + h * 64;

_Pragma("unroll") for (int d = 0; d < 64; ++d) { q[d] = qp[d]; o[d] = 0.f; }
    const float* Fh = F + (size_t)(b * 8 + h) * S; float fq = Fh[s];
    float m = -1e30f, l = 0.f;
    int smax = (s | 63);
    for (int ks = 0; ks <= smax; ++ks) {
        int kt = b * S + ks;
        const float* kp = Z + (size_t)kt * ldz + 1024 + h * 64;
        const float* vp = Z + (size_t)kt * ldz + 1536 + h * 64;
        float dot = 0.f;

_Pragma("unroll") for (int d = 0; d < 64; ++d) dot += q[d] * kp[d];
        float sc = dot * 0.125f + fq - Fh[ks];
        if (ks <= s) {
            float mn = fmaxf(m, sc); float al = expf(m - mn), pp = expf(sc - mn);
            l = l * al + pp;

_Pragma("unroll") for (int d = 0; d < 64; ++d) o[d] = o[d] * al + pp * vp[d];
            m = mn;
        }
    }
    float inv = 1.f / l;
    float* op = CAT + (size_t)t * 1024 + 512 + h * 64;

_Pragma("unroll") for (int d = 0; d < 64; ++d) op[d] = o[d] * inv;
}

struct Ws {
    float *modv, *H, *Z, *CAT, *Y, *X1, *X2, *Dp, *YG, *GL, *LOG, *ACT, *YP, *gates, *F;
    int *count, *pstart, *top_e, *pos, *tok_of_slot, *slot_of_pair;
    size_t bytes;
};
static Ws carve(void* base) {
    Ws w; char* p = (char*)base; auto take = [&](size_t bytes) { char* r = p; p += (bytes + 255) / 256 * 256; return r; };
    w.modv = (float*)take(4 * 2 * 3072 * 4);
    w.H = (float*)take((size_t)T * D * 4); w.Z = (float*)take((size_t)T * 2056 * 4); w.CAT = (float*)take((size_t)T * D * 4); w.Y = (float*)take((size_t)T * D * 4);
    w.X1 = (float*)take((size_t)T * D * 4); w.X2 = (float*)take((size_t)T * D * 4); w.Dp = (float*)take((size_t)T * 512 * 4); w.YG = (float*)take((size_t)T * 512 * 4); w.GL = (float*)take((size_t)T * 512 * 4);
    w.LOG = (float*)take((size_t)T * 32 * 4); w.ACT = (float*)take((size_t)MAXROWS * D * 4); w.YP = (float*)take((size_t)MAXROWS * D * 4); w.gates = (float*)take((size_t)T * 4 * 4); w.F = (float*)take((size_t)16 * S * 4);
    w.count = (int*)take(64 * 4); w.pstart = (int*)take(64 * 4); w.top_e = (int*)take((size_t)T * 4 * 4); w.pos = (int*)take((size_t)T * 4 * 4); w.tok_of_slot = (int*)take((size_t)MAXROWS * 4); w.slot_of_pair = (int*)take((size_t)T * 4 * 4);
    w.bytes = (size_t)(p - (char*)base); return w;
}

static void launch_gemm(hipStream_t st, const float* A, int lda, const float* B, int ldb, const float* bias, const float* colscale, float* C, int ldc, int M, int N, int K,
                        const int* pstart = nullptr, size_t strideB = 0, int strideBias = 0) {
    GemmArgs g; memset(&g, 0, sizeof(g)); g.A = A; g.lda = lda; g.B = B; g.ldb = ldb; g.bias = bias; g.colscale = colscale; g.C = C; g.ldc = ldc; g.M = M; g.N = N; g.K = K; g.pstart = pstart; g.strideB = strideB; g.strideBias = strideBias;
    dim3 grid((N + 63) / 64, (M + 63) / 64);
    hipLaunchKernelGGL(k_gemm, grid, dim3(256), 0, st, g);
}

static void moe(hipStream_t st, const Ws& w, const float* xin  , const float* modv_l1, const float* router_w, const float* router_b, const float* wgu, const float* bgu, const float* wdn, const float* bdn,
                const float* lg, const float* lb, float* xout) {
    const int EW = 256;
    hipLaunchKernelGGL(k_modulate, dim3((T * D + EW - 1) / EW), dim3(EW), 0, st, xin, modv_l1, w.H);
    launch_gemm(st, w.H, D, router_w, 32, router_b, nullptr, w.LOG, 32, T, 32, D);
    hipMemsetAsync(w.count, 0, 64 * 4, st);
    hipMemsetAsync(w.tok_of_slot, 0, (size_t)MAXROWS * 4, st);
    hipLaunchKernelGGL(k_route, dim3(T / 256), dim3(256), 0, st, w.LOG, w.count, w.top_e, w.gates, w.pos);
    hipLaunchKernelGGL(k_offsets, dim3(1), dim3(64), 0, st, w.count, w.pstart);
    hipLaunchKernelGGL(k_fill, dim3(T * 4 / 256), dim3(256), 0, st, w.top_e, w.pos, w.pstart, w.tok_of_slot, w.slot_of_pair);
    hipLaunchKernelGGL(k_moe1, dim3(1024 / 64, MAXROWS / 64), dim3(256), 0, st, w.H, w.tok_of_slot, w.pstart, wgu, bgu, w.ACT);
    launch_gemm(st, w.ACT, D, wdn, D, bdn, nullptr, w.YP, D, MAXROWS, D, D, w.pstart, (size_t)1024 * 1024, 1024);
    hipLaunchKernelGGL(k_combine, dim3((T * D + EW - 1) / EW), dim3(EW), 0, st, w.YP, w.slot_of_pair, w.gates, w.Y);
    hipLaunchKernelGGL(k_ln, dim3(T / 4), dim3(256), 0, st, xin, w.Y, modv_l1, lg, lb, xout);
}

static void forward(void* const* d_in, float* out, void* ws_base, hipStream_t st) {
    const float* x = (const float*)d_in[0]; const float* c = (const float*)d_in[1]; const float* mod_w = (const float*)d_in[2]; const float* mod_b = (const float*)d_in[3];
    const float* ln_g = (const float*)d_in[4]; const float* ln_b = (const float*)d_in[5]; const float* even_w_in = (const float*)d_in[6]; const float* pool_w = (const float*)d_in[7];
    const float* pool_scale = (const float*)d_in[8]; const float* rel_bias = (const float*)d_in[9]; const float* even_w_out = (const float*)d_in[10]; const float* odd_w_in = (const float*)d_in[11];
    const float* forget_b = (const float*)d_in[12]; const float* lam_re = (const float*)d_in[13]; const float* lam_im = (const float*)d_in[14]; const float* log_dt = (const float*)d_in[15];
    const float* b_re = (const float*)d_in[16]; const float* b_im = (const float*)d_in[17]; const float* c_re = (const float*)d_in[18]; const float* c_im = (const float*)d_in[19];
    const float* d_skip = (const float*)d_in[20]; const float* glu_w = (const float*)d_in[21]; const float* glu_b = (const float*)d_in[22]; const float* odd_w_out = (const float*)d_in[23];
    const float* router_w = (const float*)d_in[24]; const float* router_b = (const float*)d_in[25]; const float* wgu = (const float*)d_in[26]; const float* bgu = (const float*)d_in[27];
    const float* wdn = (const float*)d_in[28]; const float* bdn = (const float*)d_in[29];
    Ws w = carve(ws_base);
    const int EW = 256;
    hipLaunchKernelGGL(k_mod, dim3(4 * 3072 / 256), dim3(256), 0, st, c, mod_w, mod_b, w.modv);
    hipLaunchKernelGGL(k_modulate, dim3((T * D + EW - 1) / EW), dim3(EW), 0, st, x, w.modv + 0 * 2 * 3072, w.H);
    launch_gemm(st, w.H, D, even_w_in, 2048, nullptr, nullptr, w.Z, 2048, T, 2048, D);
    hipLaunchKernelGGL(k_pool, dim3((T * 512 + EW - 1) / EW), dim3(EW), 0, st, w.Z, 2048, w.Dp);
    for (int g = 0; g < 4; ++g) launch_gemm(st, w.Dp + g * 128, 512, pool_w + (size_t)g * 128 * 128, 128, nullptr, pool_scale + g * 128, w.CAT + g * 128, D, T, 128, 128);
    hipLaunchKernelGGL(k_chunk_attn, dim3(T * 8 / 64), dim3(64), 0, st, w.Z, 2048, rel_bias, w.CAT);
    launch_gemm(st, w.CAT, D, even_w_out, D, nullptr, nullptr, w.Y, D, T, D, D);
    hipLaunchKernelGGL(k_ln, dim3(T / 4), dim3(256), 0, st, x, w.Y, w.modv + 0 * 2 * 3072, ln_g + 0 * 1024, ln_b + 0 * 1024, w.X1);
    moe(st, w, w.X1, w.modv + 1 * 2 * 3072, router_w, router_b, wgu, bgu, wdn, bdn, ln_g + 1 * 1024, ln_b + 1 * 1024, w.X2);
    hipLaunchKernelGGL(k_modulate, dim3((T * D + EW - 1) / EW), dim3(EW), 0, st, w.X2, w.modv + 2 * 2 * 3072, w.H);
    launch_gemm(st, w.H, D, odd_w_in, 2056, nullptr, nullptr, w.Z, 2056, T, 2056, D);
    hipLaunchKernelGGL(k_s5, dim3(64), dim3(64), 0, st, w.Z, 2056, lam_re, lam_im, log_dt, b_re, b_im, c_re, c_im, d_skip, w.YG);
    launch_gemm(st, w.YG, 512, glu_w, 512, glu_b, nullptr, w.GL, 512, T, 512, 512);
    hipLaunchKernelGGL(k_glu, dim3((T * 512 + EW - 1) / EW), dim3(EW), 0, st, w.YG, w.GL, w.CAT);
    hipLaunchKernelGGL(k_fcum, dim3(1), dim3(64), 0, st, w.Z, 2056, forget_b, w.F);
    hipLaunchKernelGGL(k_fox, dim3(T * 8 / 64), dim3(64), 0, st, w.Z, 2056, w.F, w.CAT);
    launch_gemm(st, w.CAT, D, odd_w_out, D, nullptr, nullptr, w.Y, D, T, D, D);
    hipLaunchKernelGGL(k_ln, dim3(T / 4), dim3(256), 0, st, w.X2, w.Y, w.modv + 2 * 2 * 3072, ln_g + 2 * 1024, ln_b + 2 * 1024, w.X1);
    moe(st, w, w.X1, w.modv + 3 * 2 * 3072, router_w + 1024 * 32, router_b + 32, wgu + (size_t)32 * 1024 * 2048, bgu + 32 * 2048, wdn + (size_t)32 * 1024 * 1024, bdn + 32 * 1024,
        ln_g + 3 * 1024, ln_b + 3 * 1024, out);
}
}
extern "C" void kernel_launch(void* const* d_in, const int* in_sizes, int n_in, void* d_out, int out_size,
                              void* d_ws, size_t ws_size, hipStream_t stream) {
    nv::forward(d_in, (float*)d_out, d_ws, stream);
}
```

```cpp
#include <hip/hip_runtime.h>
#include <hip/hip_cooperative_groups.h>
#include <cstdio>
#include <cstdint>
#include <cstring>
#include <cmath>
#define LAS __attribute__((address_space(3)))
#define GAS __attribute__((address_space(1)))
typedef unsigned short bf16_t;
typedef short bf16x8 __attribute__((ext_vector_type(8)));
typedef short s16x4 __attribute__((ext_vector_type(4)));
typedef float f32x4 __attribute__((ext_vector_type(4)));
typedef float f32x2 __attribute__((ext_vector_type(2)));
typedef float f32x16 __attribute__((ext_vector_type(16)));
typedef unsigned u32x4 __attribute__((ext_vector_type(4)));
typedef unsigned u32x2 __attribute__((ext_vector_type(2)));
typedef __bf16 bf16x2_t __attribute__((ext_vector_type(2)));

constexpr int T_TOK = 16384, SEQ = 8192, DM = 1024, NBATCH = 2;
constexpr int ZP = 2048;
constexpr int MAXROWS = 73728;
constexpr int MAXTILES = MAXROWS / 256;
constexpr float DN_ALPHA = 1.41421356237309515f;
constexpr float LN_EPS = 1e-5f;
constexpr float LOG2E = 1.4426950408889634f;
constexpr float QSCALE = 0.125f * 1.4426950408889634f;

__device__ __forceinline__ unsigned pk2(float lo, float hi) { f32x2 v = {lo, hi}; bf16x2_t b = __builtin_convertvector(v, bf16x2_t); return __builtin_bit_cast(unsigned, b); }
__device__ __forceinline__ float bf2f(unsigned short u) { return __uint_as_float(((unsigned)u) << 16); }
__device__ __forceinline__ float bflo(unsigned w) { return __uint_as_float(w << 16); }
__device__ __forceinline__ float bfhi(unsigned w) { return __uint_as_float(w & 0xffff0000u); }
__device__ __forceinline__ float wave_sum(float v) {
#pragma unroll
    for (int o = 1; o < 64; o <<= 1) v += __shfl_xor(v, o);
    return v;
}
__device__ __forceinline__ float fast_sigmoid(float x) { return __builtin_amdgcn_rcpf(1.f + __builtin_amdgcn_exp2f(-x * LOG2E)); }
#define LDS_WAIT() asm volatile("s_waitcnt lgkmcnt(0)" ::: "memory")
#define VM_WAIT() asm volatile("s_waitcnt vmcnt(0)" ::: "memory")
namespace pg8 {
#define PG8_LAS __attribute__((address_space(3)))
typedef unsigned short bf16_t;
typedef short bf16x8 __attribute__((ext_vector_type(8)));
typedef float f32x4 __attribute__((ext_vector_type(4)));
typedef unsigned u32x4 __attribute__((ext_vector_type(4)));
constexpr int BM = 256, BK = 64, HALF = 128, HTB = HALF * BK * 2  , STAGE_BYTES = 8 * HTB, NXCD = 8, WGM = 8;

__host__ __device__ __forceinline__ int lds_byte(int r, int c) { const int st = (r >> 4) * 2 + (c >> 5), rr = r & 15, cc = c & 31, ob = rr * 64 + cc * 2; return st * 1024 + (ob ^ (((ob >> 9) & 1) << 5)); }
__host__ __device__ __forceinline__ void stage_rc(int b, int& R, int& C) { const int st = b / 1024, sb = b % 1024, swz = sb ^ (((sb >> 9) & 1) << 5); R = (st >> 1) * 16 + swz / 64; C = (st & 1) * 32 + (swz % 64) / 2; }
__host__ __device__ __forceinline__ int perm32(int rho) { const int n = rho >> 4, i = rho & 15; return 8 * (i >> 2) + 4 * n + (i & 3); }

struct Unit { int pm, pn, e; size_t boff; };
struct Gemm { const bf16_t* A; const bf16_t* Bt; int M, N, K; };

struct StaticOrder {
    int nM, nN, nwg, G, c;
    __host__ __device__ void init(int M, int N, int G_, int c_) { nM = M / BM; nN = N / BM; nwg = nM * nN; G = G_; c = c_; }
    __host__ __device__ bool next(int i, Unit& u) const {
        const long L = (long)i * G + c; if (L >= nwg) return false;
        int wgid = (int)L; { const int q = nwg / NXCD, r = nwg % NXCD, xcd = wgid % NXCD, off = wgid / NXCD; wgid = (xcd < r ? xcd * (q + 1) : r * (q + 1) + (xcd - r) * q) + off; }
        const int nig = WGM * nN, gid = wgid / nig, fm = gid * WGM, gsz = (nM - fm) < WGM ? (nM - fm) : WGM;
        u.pm = fm + ((wgid % nig) % gsz); u.pn = (wgid % nig) / gsz; u.e = 0; u.boff = 0; return true;
    }
    __device__ __forceinline__ void a_ready(const Unit&) const {}
    __device__ __forceinline__ void done(const Unit&) const {}
};

__device__ __forceinline__ unsigned cvt_pk_bf16(float lo, float hi) { unsigned r; asm volatile("v_cvt_pk_bf16_f32 %0, %1, %2" : "=v"(r) : "v"(lo), "v"(hi)); return r; }
typedef float f32x2 __attribute__((ext_vector_type(2)));

template <class Epi, class Sched, bool ALIGN_EPI = false, bool SP2 = false>
__device__ __forceinline__ void gemm_phase(PG8_LAS unsigned char* lds, const Gemm g, const Sched& S, const Epi& E) {
    const int tid = threadIdx.x, wid = __builtin_amdgcn_readfirstlane(tid >> 6), lane = tid & 63, wr = wid >> 2, wc = wid & 3, fr = lane & 15, fq = lane >> 4;
    const int K = g.K, nt = K / BK;
    unsigned voffA[2], voffB[2];
#pragma unroll
    for (int i = 0; i < 2; ++i) { int R, C; stage_rc(tid * 16 + i * 8192, R, C); const int Rb = Epi::PERM ? ((R & ~31) + perm32(R & 31)) : R;
        voffA[i] = (unsigned)(R * K + C) * 2u; voffB[i] = (unsigned)(Rb * K + C) * 2u; }
    const size_t kstep = (size_t)(BK * 2);
    const size_t hstep = (size_t)HALF * K * 2;
    const size_t tstep = 2 * hstep;
    const unsigned ldsw = (unsigned)wid * 1024u;
    const int aoff = lds_byte(wr * 64 + fr, fq * 8), boff = lds_byte(wc * 32 + fr, fq * 8);
#define PG8_SA(b, h) (((b) * 2 + (h)) * HTB)
#define PG8_SB(b, h) ((4 + (b) * 2 + (h)) * HTB)
#define PG8_STAGE(bufoff, gbase, voff) do { _Pragma("unroll") for (int _i = 0; _i < 2; ++_i) \
        __builtin_amdgcn_global_load_lds((const unsigned*)((const char*)(gbase) + (voff)[_i]), (PG8_LAS unsigned*)(lds + (bufoff) + ldsw + _i * 8192), 16, 0, 0); } while (0)
#define PG8_LDA(dst, b, h) do { _Pragma("unroll") for (int m = 0; m < 4; ++m) _Pragma("unroll") for (int k = 0; k < 2; ++k) dst[m][k] = *(const PG8_LAS bf16x8*)(lds + PG8_SA(b, h) + aoff + m * 2048 + k * 1024); } while (0)
#define PG8_LDB(dst, b, h) do { _Pragma("unroll") for (int n = 0; n < 2; ++n) _Pragma("unroll") for (int k = 0; k < 2; ++k) dst[n][k] = *(const PG8_LAS bf16x8*)(lds + PG8_SB(b, h) + boff + n * 2048 + k * 1024); } while (0)
#define PG8_MMA(ai, bj, At, Bt) do { __builtin_amdgcn_s_setprio(1); _Pragma("unroll") for (int m = 0; m < 4; ++m) _Pragma("unroll") for (int n = 0; n < 2; ++n) _Pragma("unroll") for (int k = 0; k < 2; ++k) \
        acc[ai][bj][m][n] = __builtin_amdgcn_mfma_f32_16x16x32_bf16(Bt[n][k], At[m][k], acc[ai][bj][m][n], 0, 0, 0); __builtin_amdgcn_s_setprio(0); } while (0)
#define PG8_WAIT_V(n) asm volatile("s_waitcnt vmcnt(" #n ")" ::: "memory")
#define PG8_WAIT_L(n) asm volatile("s_waitcnt lgkmcnt(" #n ")" ::: "memory")
#define PG8_BAR __builtin_amdgcn_s_barrier()
#define PG8_SCHED __builtin_amdgcn_sched_barrier(0)
    Unit cur, nxt; int ui = 0;
    if (!S.next(0, cur)) return;
    f32x4 acc[2][2][4][2];
#pragma unroll
    for (int a = 0; a < 2; ++a)
#pragma unroll
        for (int b = 0; b < 2; ++b)
#pragma unroll
            for (int m = 0; m < 4; ++m)
#pragma unroll
                for (int n = 0; n < 2; ++n) acc[a][b][m][n] = (f32x4){0.f, 0.f, 0.f, 0.f};
    bf16x8 At[4][2], B0[2][2], B1[2][2];
    const char* cA = (const char*)g.A + (size_t)cur.pm * tstep; const char* cB = (const char*)g.Bt + cur.boff + (size_t)cur.pn * tstep;
    S.a_ready(cur);
    if constexpr (SP2) {
        PG8_STAGE(PG8_SB(0, 0), cB, voffB); PG8_STAGE(PG8_SB(0, 1), cB + hstep, voffB); PG8_STAGE(PG8_SA(0, 0), cA, voffA); PG8_STAGE(PG8_SA(0, 1), cA + hstep, voffA);
        if (wr == 1) PG8_BAR;
        PG8_WAIT_V(2); PG8_BAR;
        PG8_STAGE(PG8_SB(1, 0), cB + kstep, voffB); PG8_STAGE(PG8_SA(1, 0), cA + kstep, voffA); PG8_STAGE(PG8_SB(1, 1), cB + hstep + kstep, voffB);
        PG8_WAIT_V(6); PG8_BAR;
    } else {
        PG8_STAGE(PG8_SB(0, 0), cB, voffB); PG8_STAGE(PG8_SA(0, 0), cA, voffA); PG8_STAGE(PG8_SB(0, 1), cB + hstep, voffB); PG8_STAGE(PG8_SA(0, 1), cA + hstep, voffA);
        if (wr == 1) PG8_BAR;
        PG8_WAIT_V(4); PG8_BAR;
        PG8_STAGE(PG8_SB(1, 0), cB + kstep, voffB); PG8_STAGE(PG8_SA(1, 0), cA + kstep, voffA); PG8_STAGE(PG8_SB(1, 1), cB + hstep + kstep, voffB);
        PG8_WAIT_V(6); PG8_BAR;
    }
    for (;;) {
        const bool has_next = S.next(ui + 1, nxt);
        const char* nA = has_next ? (const char*)g.A + (size_t)nxt.pm * tstep : cA; const char* nB = has_next ? (const char*)g.Bt + nxt.boff + (size_t)nxt.pn * tstep : cB;
        for (int t = 0; t < nt; t += 2) {
            const bool last = (t == nt - 2);
            const char* a1 = cA + (size_t)(t + 1) * kstep;
            const char* a2 = last ? nA : cA + (size_t)(t + 2) * kstep; const char* b2 = last ? nB : cB + (size_t)(t + 2) * kstep;
            const char* a3 = a2 + kstep; const char* b3 = b2 + kstep;
            if (last && has_next) S.a_ready(nxt);
            if constexpr (SP2) {
            PG8_LDB(B0, 0, 0); PG8_LDB(B1, 0, 1); PG8_SCHED; PG8_LDA(At, 0, 0); PG8_STAGE(PG8_SA(1, 1), a1 + hstep, voffA);
            PG8_WAIT_V(8); PG8_WAIT_L(0); PG8_BAR; PG8_MMA(0, 0, At, B0); PG8_MMA(0, 1, At, B1); PG8_BAR; PG8_SCHED;
            PG8_LDA(At, 0, 1); PG8_STAGE(PG8_SB(0, 0), b2, voffB); PG8_STAGE(PG8_SB(0, 1), b2 + hstep, voffB); PG8_STAGE(PG8_SA(0, 0), a2, voffA);
            PG8_WAIT_V(8); PG8_WAIT_L(0); PG8_BAR; PG8_MMA(1, 0, At, B0); PG8_MMA(1, 1, At, B1); PG8_BAR; PG8_SCHED;
            PG8_LDB(B0, 1, 0); PG8_LDB(B1, 1, 1); PG8_SCHED; PG8_LDA(At, 1, 0); PG8_STAGE(PG8_SA(0, 1), a2 + hstep, voffA);
            PG8_WAIT_V(8); PG8_WAIT_L(0); PG8_BAR; PG8_MMA(0, 0, At, B0); PG8_MMA(0, 1, At, B1); PG8_BAR; PG8_SCHED;
            PG8_LDA(At, 1, 1); PG8_STAGE(PG8_SB(1, 0), b3, voffB); PG8_STAGE(PG8_SB(1, 1), b3 + hstep, voffB); PG8_STAGE(PG8_SA(1, 0), a3, voffA);
            PG8_WAIT_V(8); PG8_WAIT_L(0); PG8_BAR; PG8_MMA(1, 0, At, B0); PG8_MMA(1, 1, At, B1); PG8_BAR; PG8_SCHED;
            } else {
            PG8_LDB(B0, 0, 0); PG8_SCHED; PG8_LDA(At, 0, 0); PG8_STAGE(PG8_SA(1, 1), a1 + hstep, voffA);
            PG8_WAIT_L(8); PG8_BAR; PG8_WAIT_L(0); PG8_MMA(0, 0, At, B0); PG8_BAR; PG8_SCHED;
            PG8_LDB(B1, 0, 1); PG8_STAGE(PG8_SB(0, 0), b2, voffB);
            PG8_BAR; PG8_WAIT_L(0); PG8_MMA(0, 1, At, B1); PG8_BAR;
            PG8_LDA(At, 0, 1); PG8_STAGE(PG8_SA(0, 0), a2, voffA);
            PG8_BAR; PG8_WAIT_L(0); PG8_MMA(1, 0, At, B0); PG8_BAR; PG8_SCHED;
            PG8_STAGE(PG8_SB(0, 1), b2 + hstep, voffB);
            PG8_WAIT_V(6); PG8_BAR; PG8_MMA(1, 1, At, B1); PG8_BAR;
            PG8_LDB(B0, 1, 0); PG8_SCHED; PG8_LDA(At, 1, 0); PG8_STAGE(PG8_SA(0, 1), a2 + hstep, voffA);
            PG8_WAIT_L(8); PG8_BAR; PG8_WAIT_L(0); PG8_MMA(0, 0, At, B0); PG8_BAR; PG8_SCHED;
            PG8_LDB(B1, 1, 1); PG8_STAGE(PG8_SB(1, 0), b3, voffB);
            PG8_BAR; PG8_WAIT_L(0); PG8_MMA(0, 1, At, B1); PG8_BAR;
            PG8_LDA(At, 1, 1); PG8_STAGE(PG8_SA(1, 0), a3, voffA);
            PG8_BAR; PG8_WAIT_L(0); PG8_MMA(1, 0, At, B0); PG8_BAR; PG8_SCHED;
            PG8_STAGE(PG8_SB(1, 1), b3 + hstep, voffB);
            PG8_WAIT_V(6); PG8_BAR; PG8_MMA(1, 1, At, B1); PG8_BAR;
            }
        }
        if constexpr (ALIGN_EPI) { if (wr == 0) PG8_BAR; }
        if constexpr (!Epi::AFTER_DRAIN) { E(acc, cur, wr, wc, fr, fq); S.done(cur); }
        if (!has_next) break;
#pragma unroll
        for (int a = 0; a < 2; ++a)
#pragma unroll
            for (int b = 0; b < 2; ++b)
#pragma unroll
                for (int m = 0; m < 4; ++m)
#pragma unroll
                    for (int n = 0; n < 2; ++n) acc[a][b][m][n] = (f32x4){0.f, 0.f, 0.f, 0.f};
        cur = nxt; cA = nA; cB = nB; ++ui;
        if constexpr (ALIGN_EPI) { if (wr == 1) PG8_BAR; }
    }
    PG8_WAIT_V(0);
    if constexpr (!ALIGN_EPI) { if (wr == 0) PG8_BAR; }
    PG8_BAR;
    if constexpr (Epi::AFTER_DRAIN) { E.fused(acc, cur, wr, wc, fr, fq, lds, wid, lane); S.done(cur); }
#undef PG8_SA
#undef PG8_SB
#undef PG8_STAGE
#undef PG8_LDA
#undef PG8_LDB
#undef PG8_MMA
#undef PG8_WAIT_V
#undef PG8_WAIT_L
#undef PG8_BAR
#undef PG8_SCHED
}
}

#ifndef PG8_SP2
#define PG8_SP2 true
#endif
#ifndef PG8_ALIGN
#define PG8_ALIGN true
#endif
namespace epi {
using pg8::Unit; using pg8::BM; using pg8::HALF;

struct EpiZ {
    static constexpr bool PERM = true, AFTER_DRAIN = false;
    bf16_t* O; int ldc; int sc_lo, sc_hi; float sc;
    __device__ __forceinline__ void operator()(const f32x4 (&acc)[2][2][4][2], const Unit& u, int wr, int wc, int fr, int fq) const {
        const int row0 = u.pm * BM + wr * 64 + fr; const int colt = u.pn * BM;
        const float s = (colt >= sc_lo && colt < sc_hi) ? sc : 1.f;
        const int col0 = colt + wc * 32 + 8 * fq;
#pragma unroll
        for (int ai = 0; ai < 2; ++ai)
#pragma unroll
            for (int m = 0; m < 4; ++m) { bf16_t* rowp = O + (size_t)(row0 + ai * HALF + m * 16) * ldc + col0;
#pragma unroll
                for (int bj = 0; bj < 2; ++bj) { const f32x4 v0 = acc[ai][bj][m][0] * s, v1 = acc[ai][bj][m][1] * s;
                    u32x4 w; w.x = pk2(v0[0], v0[1]); w.y = pk2(v0[2], v0[3]); w.z = pk2(v1[0], v1[1]); w.w = pk2(v1[2], v1[3]);
                    *(u32x4*)(rowp + bj * HALF) = w; } }
    }
};
struct EpiF32 {
    static constexpr bool PERM = false, AFTER_DRAIN = false;
    float* O; int ldc;
    __device__ __forceinline__ void operator()(const f32x4 (&acc)[2][2][4][2], const Unit& u, int wr, int wc, int fr, int fq) const {
        const int row0 = u.pm * BM + wr * 64 + fr; const int col0 = u.pn * BM + wc * 32 + 4 * fq;
#pragma unroll
        for (int ai = 0; ai < 2; ++ai)
#pragma unroll
            for (int m = 0; m < 4; ++m) { float* rowp = O + (size_t)(row0 + ai * HALF + m * 16) * ldc + col0;
#pragma unroll
                for (int bj = 0; bj < 2; ++bj)
#pragma unroll
                    for (int n = 0; n < 2; ++n) *(f32x4*)(rowp + bj * HALF + n * 16) = acc[ai][bj][m][n]; }
    }
};
struct EpiSwiglu {
    static constexpr bool PERM = true, AFTER_DRAIN = false;
    bf16_t* O; const float* bias;
    __device__ __forceinline__ void operator()(const f32x4 (&acc)[2][2][4][2], const Unit& u, int wr, int wc, int fr, int fq) const {
        const int row0 = u.pm * BM + wr * 64 + fr; const int cc = u.pn * 128 + wc * 32 + 8 * fq;
        const float* bg = bias + (size_t)u.e * 2048 + cc; const float* bu = bg + 1024;
        const f32x4 bg0 = *(const f32x4*)bg, bg1 = *(const f32x4*)(bg + 4), bu0 = *(const f32x4*)bu, bu1 = *(const f32x4*)(bu + 4);
#pragma unroll
        for (int ai = 0; ai < 2; ++ai)
#pragma unroll
            for (int m = 0; m < 4; ++m) {
                float r[8];
#pragma unroll
                for (int n = 0; n < 2; ++n) { const f32x4 g4 = acc[ai][0][m][n] + (n ? bg1 : bg0), u4 = acc[ai][1][m][n] + (n ? bu1 : bu0);
#pragma unroll
                    for (int i = 0; i < 4; ++i) { const float gate = fminf(g4[i], 7.0f); const float up = fminf(fmaxf(u4[i], -7.0f), 7.0f);
                        const float glu = gate * __builtin_amdgcn_rcpf(1.f + __builtin_amdgcn_exp2f(-1.702f * LOG2E * gate)); r[n * 4 + i] = (up + 1.0f) * glu; } }
                u32x4 w; w.x = pk2(r[0], r[1]); w.y = pk2(r[2], r[3]); w.z = pk2(r[4], r[5]); w.w = pk2(r[6], r[7]);
                *(u32x4*)(O + (size_t)(row0 + ai * HALF + m * 16) * 1024 + cc) = w; }
    }
};
struct EpiBiasBf16 {
    static constexpr bool PERM = true, AFTER_DRAIN = false;
    bf16_t* O; const float* bias;
    __device__ __forceinline__ void operator()(const f32x4 (&acc)[2][2][4][2], const Unit& u, int wr, int wc, int fr, int fq) const {
        const int row0 = u.pm * BM + wr * 64 + fr; const int col0 = u.pn * BM + wc * 32 + 8 * fq;
        const float* bp = bias + (size_t)u.e * 1024 + col0;
#pragma unroll
        for (int bj = 0; bj < 2; ++bj) { const f32x4 b0 = *(const f32x4*)(bp + bj * HALF), b1 = *(const f32x4*)(bp + bj * HALF + 4);
#pragma unroll
            for (int ai = 0; ai < 2; ++ai)
#pragma unroll
                for (int m = 0; m < 4; ++m) { const f32x4 v0 = acc[ai][bj][m][0] + b0, v1 = acc[ai][bj][m][1] + b1;
                    u32x4 w; w.x = pk2(v0[0], v0[1]); w.y = pk2(v0[2], v0[3]); w.z = pk2(v1[0], v1[1]); w.w = pk2(v1[2], v1[3]);
                    *(u32x4*)(O + (size_t)(row0 + ai * HALF + m * 16) * 1024 + col0 + bj * HALF) = w; } }
    }
};
struct EpiGlu {
    static constexpr bool PERM = true, AFTER_DRAIN = false;
    bf16_t* O; const bf16_t* YG; const float* bias;
    __device__ __forceinline__ void operator()(const f32x4 (&acc)[2][2][4][2], const Unit& u, int wr, int wc, int fr, int fq) const {
        const int row0 = u.pm * BM + wr * 64 + fr; const int col0 = u.pn * BM + wc * 32 + 8 * fq;
#pragma unroll
        for (int bj = 0; bj < 2; ++bj) { const f32x4 b0 = *(const f32x4*)(bias + col0 + bj * HALF), b1 = *(const f32x4*)(bias + col0 + bj * HALF + 4);
#pragma unroll
            for (int ai = 0; ai < 2; ++ai)
#pragma unroll
                for (int m = 0; m < 4; ++m) { const size_t row = (size_t)(row0 + ai * HALF + m * 16);
                    const u32x4 y = *(const u32x4*)(YG + row * 512 + col0 + bj * HALF);
                    const f32x4 v0 = acc[ai][bj][m][0] + b0, v1 = acc[ai][bj][m][1] + b1;
                    u32x4 w;
                    w.x = pk2(bflo(y.x) * fast_sigmoid(v0[0]), bfhi(y.x) * fast_sigmoid(v0[1])); w.y = pk2(bflo(y.y) * fast_sigmoid(v0[2]), bfhi(y.y) * fast_sigmoid(v0[3]));
                    w.z = pk2(bflo(y.z) * fast_sigmoid(v1[0]), bfhi(y.z) * fast_sigmoid(v1[1])); w.w = pk2(bflo(y.w) * fast_sigmoid(v1[2]), bfhi(y.w) * fast_sigmoid(v1[3]));
                    *(u32x4*)(O + row * 1024 + col0 + bj * HALF) = w; } }
    }
};
struct MoeOrder {
    int R, ncol, c; const int* tile_e; size_t estride;
    __device__ bool next(int i, Unit& u) const {
        const int xcd = c & 7, j = c >> 3, rp = 32 / ncol;
        const int rt = (i * 8 + xcd) * rp + j / ncol; if (rt >= R) return false;
        u.pm = rt; u.pn = j % ncol; u.e = tile_e[rt]; u.boff = (size_t)u.e * estride; return true;
    }
    __device__ __forceinline__ void a_ready(const Unit&) const {}
    __device__ __forceinline__ void done(const Unit&) const {}
};
}
namespace att {
constexpr int SLOTB = 8192;
constexpr int L_K = 0, L_V = 2 * SLOTB, L_WS = 4 * SLOTB, L_OST = L_WS + 8 * 64 * 4, L_FK = L_OST + 8 * 4096, L_TAB = L_FK + 8192 * 4, L_END = L_TAB + 272 * 4;
__device__ __forceinline__ int crow(int r, int hi) { return (r & 3) + 8 * (r >> 2) + 4 * hi; }
#define SBAR() __builtin_amdgcn_sched_barrier(0)
__device__ __forceinline__ void glds16(const void* gsrc, unsigned lds_dst) { unsigned keep;
    asm volatile("s_mov_b32 %0, m0\n\ts_mov_b32 m0, %2\n\ts_nop 0\n\tglobal_load_lds_dwordx4 %1, off\n\ts_mov_b32 m0, %0" : "=&s"(keep) : "v"(gsrc), "s"(lds_dst) : "memory"); }
#define WAIT_BAR0() asm volatile("s_waitcnt vmcnt(0) lgkmcnt(0)\n\ts_barrier" ::: "memory")
__device__ __forceinline__ void qkt(f32x16& p0, f32x16& p1, const LAS char* Kslot, const bf16x8* qr, int r32, int hi) {
    const LAS char* kb = Kslot + hi * 1024 + r32 * 16;
    const f32x16 z = {};
#pragma unroll
    for (int d0 = 0; d0 < 4; ++d0) {
        const bf16x8 b0 = *(const LAS bf16x8*)(kb + d0 * 2048);
        const bf16x8 b1 = *(const LAS bf16x8*)(kb + d0 * 2048 + 512);
        if (d0 == 0) { p0 = __builtin_amdgcn_mfma_f32_32x32x16_bf16(b0, qr[0], z, 0, 0, 0); p1 = __builtin_amdgcn_mfma_f32_32x32x16_bf16(b1, qr[0], z, 0, 0, 0); }
        else { p0 = __builtin_amdgcn_mfma_f32_32x32x16_bf16(b0, qr[d0], p0, 0, 0, 0); p1 = __builtin_amdgcn_mfma_f32_32x32x16_bf16(b1, qr[d0], p1, 0, 0, 0); } }
}
__device__ __forceinline__ float rowmax(const f32x16& p0, const f32x16& p1) {
    float a = fmaxf(fmaxf(p0[0], p0[1]), p1[0]), b = fmaxf(fmaxf(p0[2], p0[3]), p1[1]); a = fmaxf(fmaxf(a, p1[2]), p1[3]);
#pragma unroll
    for (int r = 4; r < 16; r += 4) { a = fmaxf(fmaxf(a, p0[r]), p0[r + 1]); b = fmaxf(fmaxf(b, p0[r + 2]), p0[r + 3]); a = fmaxf(fmaxf(a, p1[r]), p1[r + 1]); b = fmaxf(fmaxf(b, p1[r + 2]), p1[r + 3]); }
    const float m = fmaxf(a, b);
    auto rr = __builtin_amdgcn_permlane32_swap(__float_as_uint(m), __float_as_uint(m), false, false);
    return fmaxf(__uint_as_float(rr[0]), __uint_as_float(rr[1]));
}
__device__ __forceinline__ void pv(f32x16* o, int vb, bf16x8 pa0, bf16x8 pa1, bf16x8 pa2, bf16x8 pa3) {
#pragma unroll
    for (int d0 = 0; d0 < 2; ++d0) { s16x4 lo[4], hi[4];
#pragma unroll
        for (int ks = 0; ks < 4; ++ks) {
            asm volatile("ds_read_b64_tr_b16 %0,%1 offset:%c2" : "=&v"(lo[ks]) : "v"(vb), "i"(d0 * 4096 + ks * 1024) : "memory");
            asm volatile("ds_read_b64_tr_b16 %0,%1 offset:%c2" : "=&v"(hi[ks]) : "v"(vb), "i"(d0 * 4096 + ks * 1024 + 512) : "memory"); }
        asm volatile("s_waitcnt lgkmcnt(0)" ::: "memory"); SBAR();
#define PKV(k) (bf16x8){lo[k][0], lo[k][1], lo[k][2], lo[k][3], hi[k][0], hi[k][1], hi[k][2], hi[k][3]}
        o[d0] = __builtin_amdgcn_mfma_f32_32x32x16_bf16(pa0, PKV(0), o[d0], 0, 0, 0);
        o[d0] = __builtin_amdgcn_mfma_f32_32x32x16_bf16(pa1, PKV(1), o[d0], 0, 0, 0);
        o[d0] = __builtin_amdgcn_mfma_f32_32x32x16_bf16(pa2, PKV(2), o[d0], 0, 0, 0);
        o[d0] = __builtin_amdgcn_mfma_f32_32x32x16_bf16(pa3, PKV(3), o[d0], 0, 0, 0);
#undef PKV
    }
}
template <int MODE>
__device__ __forceinline__ void attn_unit(int b, int h, int qb, int jlo, const bf16_t* Z, bf16_t* CAT, const float* F2bh, LAS char* shm) {
    const int tid = threadIdx.x, lane = tid & 63, r32 = lane & 31, hi = lane >> 5; const int wid = __builtin_amdgcn_readfirstlane(tid >> 6);
    const long rowbase = (long)b * SEQ; const int q0 = qb * 256;
    const bf16_t* Qw = Z + (rowbase + q0 + wid * 32) * ZP + 512 + h * 64;
    const bf16_t* Kh = Z + rowbase * ZP + 1024 + h * 64; const bf16_t* Vh = Z + rowbase * ZP + 1536 + h * 64;
    const unsigned lds0 = (unsigned)(uintptr_t)shm;
    LAS float* wsf = (LAS float*)(shm + L_WS) + wid * 64;
    const bf16_t* ksrc = Kh + (long)lane * ZP + wid * 8;
    const bf16_t* vsrc = Vh + (long)(16 * (wid & 3) + (lane >> 2)) * ZP + (wid >> 2) * 32 + (lane & 3) * 8;
    const unsigned kdst = lds0 + L_K + wid * 1024, vdst = lds0 + L_V + wid * 1024;
#define DMA_K(t, slot) glds16(ksrc + (long)(t) * 64 * ZP, (unsigned)__builtin_amdgcn_readfirstlane(kdst + (slot)))
#define DMA_V(t, slot) glds16(vsrc + (long)(t) * 64 * ZP, (unsigned)__builtin_amdgcn_readfirstlane(vdst + (slot)))
    const int vb0 = (int)(lds0 + L_V) + ((lane >> 4) & 1) * 32 + (lane & 3) * 8 + (4 * hi + ((lane & 15) >> 2)) * 64;
    const int jhi = 4 * qb + 3;
    int mylo, myhi;
    if (MODE == 0) { const int cw = 4 * qb + (wid >> 1); mylo = cw - 8 < 0 ? 0 : cw - 8; myhi = cw; }
    else { mylo = jlo; myhi = 4 * qb + (wid >> 1); }
    DMA_K(jlo, 0); DMA_V(jlo, 0);
    float fq = 0.f;
    if (MODE == 1) {
        LAS float* fk = (LAS float*)(shm + L_FK); const int cnt = q0 + 256 - 64 * jlo;
        for (int i = tid; i < cnt; i += 512) fk[i] = F2bh[64 * jlo + i];
        fq = F2bh[q0 + wid * 32 + r32];
    }
    bf16x8 qr[4];
#pragma unroll
    for (int d0 = 0; d0 < 4; ++d0) qr[d0] = *(const bf16x8*)(Qw + (long)r32 * ZP + d0 * 16 + hi * 8);
    float m = -1e30f, l = 0.f; f32x16 o[2]; o[0] = f32x16{}; o[1] = f32x16{};
    const int qs = q0 + wid * 32 + r32;
    int slot = 0;
    for (int j = jlo; j <= jhi; ++j) {
        WAIT_BAR0();
        if (j < jhi) { DMA_K(j + 1, slot ^ SLOTB); DMA_V(j + 1, slot ^ SLOTB); }
        if (j >= mylo && j <= myhi) {
            f32x16 p0, p1;
            qkt(p0, p1, shm + L_K + slot, qr, r32, hi);
            if (MODE == 1) {
                const LAS float* fkl = (const LAS float*)(shm + L_FK) + (j - jlo) * 64 + 4 * hi;
#pragma unroll
                for (int r4 = 0; r4 < 4; ++r4) { const f32x4 a = *(const LAS f32x4*)(fkl + 8 * r4), c = *(const LAS f32x4*)(fkl + 32 + 8 * r4);
#pragma unroll
                    for (int i = 0; i < 4; ++i) { p0[4 * r4 + i] += fq - a[i]; p1[4 * r4 + i] += fq - c[i]; } }
                if (j == myhi) {
                    const int kb = 64 * j + 4 * hi;
#pragma unroll
                    for (int r = 0; r < 16; ++r) { const int kv = kb + (r & 3) + 8 * (r >> 2); if (kv > qs) p0[r] = -INFINITY; if (kv + 32 > qs) p1[r] = -INFINITY; }
                }
            } else {
                const LAS float* tab = (const LAS float*)(shm + L_TAB);
                const int dmin = (q0 + wid * 32) - (64 * j + 63);
                if (dmin >= 128) { const float c = tab[256];
#pragma unroll
                    for (int r = 0; r < 16; ++r) { p0[r] += c; p1[r] += c; } }
                else { const int base = qs - 64 * j - 4 * hi + 128;
#pragma unroll
                    for (int r = 0; r < 16; ++r) { int i0 = base - ((r & 3) + 8 * (r >> 2)); int i1 = i0 - 32;
                        i0 = i0 < 0 ? 0 : (i0 > 256 ? 256 : i0); i1 = i1 < 0 ? 0 : (i1 > 256 ? 256 : i1);
                        p0[r] += tab[i0]; p1[r] += tab[i1]; } }
            }
            const float rm = rowmax(p0, p1);
            const float mn = fmaxf(m, rm); const float alpha = __builtin_amdgcn_exp2f(m - mn); m = mn;
            float s0 = 0.f, s1 = 0.f;
#pragma unroll
            for (int r = 0; r < 16; ++r) { p0[r] = __builtin_amdgcn_exp2f(p0[r] - mn); p1[r] = __builtin_amdgcn_exp2f(p1[r] - mn); s0 += p0[r]; s1 += p1[r]; }
            l = l * alpha + (s0 + s1);
            if (hi == 0) wsf[r32] = alpha;
            LDS_WAIT();
#pragma unroll
            for (int r4 = 0; r4 < 4; ++r4) { const f32x4 a = *(const LAS f32x4*)(wsf + 8 * r4 + 4 * hi);
#pragma unroll
                for (int i = 0; i < 4; ++i) { o[0][4 * r4 + i] *= a[i]; o[1][4 * r4 + i] *= a[i]; } }
            u32x4 pw0, pw1, pw2, pw3;
            pw0 = (u32x4){pk2(p0[0], p0[1]), pk2(p0[2], p0[3]), pk2(p0[4], p0[5]), pk2(p0[6], p0[7])};
            pw1 = (u32x4){pk2(p0[8], p0[9]), pk2(p0[10], p0[11]), pk2(p0[12], p0[13]), pk2(p0[14], p0[15])};
            pw2 = (u32x4){pk2(p1[0], p1[1]), pk2(p1[2], p1[3]), pk2(p1[4], p1[5]), pk2(p1[6], p1[7])};
            pw3 = (u32x4){pk2(p1[8], p1[9]), pk2(p1[10], p1[11]), pk2(p1[12], p1[13]), pk2(p1[14], p1[15])};
            SBAR();
            pv(o, vb0 + slot, __builtin_bit_cast(bf16x8, pw0), __builtin_bit_cast(bf16x8, pw1), __builtin_bit_cast(bf16x8, pw2), __builtin_bit_cast(bf16x8, pw3));
        }
        slot ^= SLOTB;
    }
    { auto rr = __builtin_amdgcn_permlane32_swap(__float_as_uint(l), __float_as_uint(l), false, false); l = __uint_as_float(rr[0]) + __uint_as_float(rr[1]); }
    if (hi == 0) wsf[32 + r32] = l;
    LDS_WAIT();
    float rli[16];
#pragma unroll
    for (int r = 0; r < 16; ++r) rli[r] = __builtin_amdgcn_rcpf(wsf[32 + crow(r, hi)]);
    bf16_t* Ow = CAT + (rowbase + q0 + wid * 32) * 1024 + 512 + h * 64;
    { LAS bf16_t* stg = (LAS bf16_t*)(shm + L_OST) + wid * 2048;
#pragma unroll
        for (int r = 0; r < 16; ++r) { const int orow = crow(r, hi);
#pragma unroll
            for (int d0 = 0; d0 < 2; ++d0) stg[orow * 64 + d0 * 32 + r32] = (bf16_t)(pk2(o[d0][r] * rli[r], 0.f) & 0xffffu); }
        LDS_WAIT();
#pragma unroll
        for (int i = 0; i < 4; ++i) { const int row = i * 8 + (lane >> 3), ch = lane & 7; const u32x4 v = *(const LAS u32x4*)(stg + row * 64 + ch * 8); *(u32x4*)(Ow + (long)row * 1024 + ch * 8) = v; } }
    asm volatile("s_waitcnt lgkmcnt(0)\n\ts_barrier" ::: "memory");
#undef DMA_K
#undef DMA_V
}
#undef SBAR
#undef WAIT_BAR0
}
namespace thin {
using att::crow;
__device__ __forceinline__ void ada_mod(const float* c, const float* mod_w, const float* mod_b, float* modv, LAS unsigned char* lds, int tid, int lane, int wid) {
    LAS float* sc = (LAS float*)lds;
    LAS float* part = sc + 2048;
    for (int i = tid; i < 2048; i += 512) { const float v = c[i]; sc[i] = v / (1.f + __expf(-v)); }
    __syncthreads();
    for (int item = blockIdx.x; item < 192; item += gridDim.x) {
        const int lj = item / 48, cg = item % 48, n = cg * 64 + lane;
        const float* w = mod_w + (size_t)lj * 1024 * 3072 + n;
        float a0 = 0.f, a1 = 0.f;
#pragma unroll 16
        for (int kk = 0; kk < 128; ++kk) { const int k = wid * 128 + kk; const float wv = w[(size_t)k * 3072]; a0 += sc[k] * wv; a1 += sc[1024 + k] * wv; }
        part[(wid * 2 + 0) * 64 + lane] = a0; part[(wid * 2 + 1) * 64 + lane] = a1;
        __syncthreads();
        if (wid < 2) { float s = 0.f;
#pragma unroll
            for (int w8 = 0; w8 < 8; ++w8) s += part[(w8 * 2 + wid) * 64 + lane];
            modv[(lj * 2 + wid) * 3072 + n] = s + mod_b[lj * 3072 + n]; }
        __syncthreads();
    }
}
__device__ __forceinline__ void tr_item(const float* W, int ldw, int k0, int n0, bf16_t* WT, int ldt, size_t drow, int dk, LAS float* scr, int lane) {
    float v[32];
#pragma unroll
    for (int i = 0; i < 32; ++i) { const int kk = 2 * i + (lane >> 5); v[i] = W[(size_t)(k0 + kk) * ldw + n0 + (lane & 31)]; }
#pragma unroll
    for (int i = 0; i < 32; ++i) scr[(2 * i + (lane >> 5)) * 33 + (lane & 31)] = v[i];
    LDS_WAIT(); asm volatile("" ::: "memory");
    const int c = lane & 7;
#pragma unroll
    for (int j = 0; j < 4; ++j) { const int n = (lane >> 3) + 8 * j; const LAS float* s = scr + (8 * c) * 33 + n;
        u32x4 o; o.x = pk2(s[0 * 33], s[1 * 33]); o.y = pk2(s[2 * 33], s[3 * 33]); o.z = pk2(s[4 * 33], s[5 * 33]); o.w = pk2(s[6 * 33], s[7 * 33]);
        *(u32x4*)(WT + (drow + n) * (size_t)ldt + dk + k0 + 8 * c) = o; }
    LDS_WAIT(); asm volatile("" ::: "memory");
}
__device__ __forceinline__ void tr_matrix_item(const float* W, int ldw, int N, int it, bf16_t* WT, int ldt, int dk, LAS float* scr, int lane) {
    const int nblk = N / 32, kb = it / nblk, nb = it % nblk;
    tr_item(W, ldw, 64 * kb, 32 * nb, WT, ldt, (size_t)(32 * nb), dk, scr, lane);
}
__device__ __forceinline__ void tr_gu_item(const float* W, int it, bf16_t* WT, LAS float* scr, int lane) {
    const int kb = it / 64, nb = it % 64, n0 = 32 * nb;
    const int n2 = n0 & 1023; const size_t drow = (size_t)((n2 >> 7) * 256 + (n0 >= 1024 ? 128 : 0) + (n2 & 127));
    tr_item(W, 2048, 64 * kb, n0, WT, 1024, drow - 0, 0, scr, lane);
}
__device__ __forceinline__ void fold_item(const float* pool_w, const float* pool_scale, const float* w_out, int it, bf16_t* WT, int lane) {
    const int kb = it >> 4, nb = it & 15, n = nb * 64 + lane, k0 = kb * 8, g = k0 >> 7;
    float acc[8] = {0.f, 0.f, 0.f, 0.f, 0.f, 0.f, 0.f, 0.f};
    const float* pw = pool_w + (size_t)g * 128 * 128 + (size_t)(k0 & 127) * 128;
#pragma unroll 4
    for (int d = 0; d < 128; ++d) { const float wv = w_out[(size_t)(g * 128 + d) * 1024 + n] * pool_scale[g * 128 + d];
#pragma unroll
        for (int kk = 0; kk < 8; ++kk) acc[kk] += pw[kk * 128 + d] * wv; }
    u32x4 o; o.x = pk2(acc[0], acc[1]); o.y = pk2(acc[2], acc[3]); o.z = pk2(acc[4], acc[5]); o.w = pk2(acc[6], acc[7]);
    *(u32x4*)(WT + (size_t)n * 1024 + k0) = o;
}
__device__ __forceinline__ void mod_row(const float* xrow, const float* mv, bf16_t* orow, int lane) {
#pragma unroll
    for (int j = 0; j < 4; ++j) { const int col = 4 * lane + 256 * j;
        const f32x4 x = *(const f32x4*)(xrow + col), sh = *(const f32x4*)(mv + col), sc = *(const f32x4*)(mv + 1024 + col);
        const f32x4 h = x * (1.f + sc) + sh; u32x2 w; w.x = pk2(h[0], h[1]); w.y = pk2(h[2], h[3]); *(u32x2*)(orow + col) = w; }
}
__device__ __forceinline__ void pool_row(const bf16_t* Z, int t, bf16_t* CAT, int lane) {
    const int s = t & (SEQ - 1), g = lane >> 4, win = 2 << g;
    float acc[8] = {0.f, 0.f, 0.f, 0.f, 0.f, 0.f, 0.f, 0.f}, own[8];
#pragma unroll
    for (int i = 0; i < 16; ++i) {
        if (i < win && s - i >= 0) { const u32x4 w = *(const u32x4*)(Z + (size_t)(t - i) * ZP + 8 * lane);
            const float f[8] = {bflo(w.x), bfhi(w.x), bflo(w.y), bfhi(w.y), bflo(w.z), bfhi(w.z), bflo(w.w), bfhi(w.w)};
#pragma unroll
            for (int q = 0; q < 8; ++q) { acc[q] += f[q]; if (i == 0) own[q] = f[q]; } } }
    const int cnt = (s + 1 < win) ? s + 1 : win; const float inv = 1.f / (float)cnt;
    u32x4 o; o.x = pk2(acc[0] * inv - own[0], acc[1] * inv - own[1]); o.y = pk2(acc[2] * inv - own[2], acc[3] * inv - own[3]);
    o.z = pk2(acc[4] * inv - own[4], acc[5] * inv - own[5]); o.w = pk2(acc[6] * inv - own[6], acc[7] * inv - own[7]);
    *(u32x4*)(CAT + (size_t)t * 1024 + 8 * lane) = o;
}
struct LnrArgs { const float* xres; const float* Y; const float* mvA; const float* mvB; const float* lg; const float* lb; float* X1; bf16_t* H2; const bf16_t* WrT; const float* rb;
                 unsigned* count; int* top_e; float* gates; int* pos; };
__device__ __forceinline__ void lnr_phase(const LnrArgs& a, LAS unsigned char* lds, int tid, int lane, int wid) {
    constexpr int AP = 2064;
    LAS unsigned char* At = lds; LAS float* red = (LAS float*)(lds + 32 * AP); LAS float* lg2 = red + 8 * 32 * 33;
    const int r32 = lane & 31, hi = lane >> 5;
    for (int tile = blockIdx.x; tile < T_TOK / 32; tile += gridDim.x) {
#pragma unroll 1
        for (int q = 0; q < 4; ++q) { const int tl = wid * 4 + q, t = tile * 32 + tl, b = t / SEQ;
            const float* xr = a.xres + (size_t)t * DM; const float* yr = a.Y + (size_t)t * DM; const float* gA = a.mvA + b * 3072 + 2048; const float* mB = a.mvB + b * 3072;
            f32x4 v[4]; float s = 0.f;
#pragma unroll
            for (int j = 0; j < 4; ++j) { const int col = 4 * lane + 256 * j; const f32x4 x = *(const f32x4*)(xr + col), y = *(const f32x4*)(yr + col), g = *(const f32x4*)(gA + col);
                v[j] = DN_ALPHA * x + (1.f + g) * y; s += (v[j][0] + v[j][1]) + (v[j][2] + v[j][3]); }
            const float mean = wave_sum(s) * (1.f / DM); float s2 = 0.f;
#pragma unroll
            for (int j = 0; j < 4; ++j) { v[j] = v[j] - mean; s2 += (v[j][0] * v[j][0] + v[j][1] * v[j][1]) + (v[j][2] * v[j][2] + v[j][3] * v[j][3]); }
            const float rstd = 1.f / sqrtf(wave_sum(s2) * (1.f / DM) + LN_EPS);
#pragma unroll
            for (int j = 0; j < 4; ++j) { const int col = 4 * lane + 256 * j; const f32x4 g = *(const f32x4*)(a.lg + col), bb = *(const f32x4*)(a.lb + col);
                const f32x4 x1 = v[j] * rstd * g + bb; *(f32x4*)(a.X1 + (size_t)t * DM + col) = x1;
                const f32x4 sh = *(const f32x4*)(mB + col), sc = *(const f32x4*)(mB + 1024 + col); const f32x4 h = x1 * (1.f + sc) + sh;
                u32x2 w; w.x = pk2(h[0], h[1]); w.y = pk2(h[2], h[3]);
                *(u32x2*)(a.H2 + (size_t)t * DM + col) = w; *(LAS u32x2*)(At + tl * AP + col * 2) = w; }
        }
        __syncthreads();
        { f32x16 acc = {};
#pragma unroll
            for (int s = 0; s < 8; ++s) { const int kb = 128 * wid + 16 * s + 8 * hi;
                const bf16x8 af = *(const LAS bf16x8*)(At + r32 * AP + kb * 2); const bf16x8 bfr = *(const bf16x8*)(a.WrT + (size_t)r32 * 1024 + kb);
                acc = __builtin_amdgcn_mfma_f32_32x32x16_bf16(af, bfr, acc, 0, 0, 0); }
#pragma unroll
            for (int r = 0; r < 16; ++r) red[(wid * 32 + crow(r, hi)) * 33 + r32] = acc[r]; }
        __syncthreads();
        { const int tok = tid >> 4;
#pragma unroll
            for (int q = 0; q < 2; ++q) { const int e = (tid & 15) * 2 + q; float s = a.rb[e];
#pragma unroll
                for (int w = 0; w < 8; ++w) s += red[(w * 32 + tok) * 33 + e];
                lg2[tok * 33 + e] = s; } }
        __syncthreads();
        if (wid == 0) {
            const bool act = lane < 32; const int tok = lane & 31, t = tile * 32 + tok;
            float v[32];
#pragma unroll
            for (int i = 0; i < 32; ++i) v[i] = lg2[tok * 33 + i];
            int e[4]; float tv[4]; unsigned taken = 0u;
#pragma unroll
            for (int k = 0; k < 4; ++k) { int bi = 0; float bv = -INFINITY;
#pragma unroll
                for (int i = 0; i < 32; ++i) { const bool ok = !((taken >> i) & 1u) && (v[i] > bv); bv = ok ? v[i] : bv; bi = ok ? i : bi; }
                e[k] = bi; tv[k] = bv; taken |= 1u << bi; }
            float ex[4], sum = 0.f;
#pragma unroll
            for (int k = 0; k < 4; ++k) { ex[k] = __expf(tv[k] - tv[0]); sum += ex[k]; }
            const float inv = 1.f / sum;
            int cnt = 0; int rank[4];
#pragma unroll
            for (int k = 0; k < 4; ++k) { const int ek = act ? e[k] : -1; const int prev = __shfl(cnt, e[k]); int myrank = 0;
#pragma unroll 1
                for (int ee = 0; ee < 32; ++ee) { const unsigned long long mk = __ballot(ek == ee); if (ek == ee) myrank = __popcll(mk & ((1ull << lane) - 1ull)); if (lane == ee) cnt += __popcll(mk); }
                rank[k] = prev + myrank; }
            int base = 0; if (act && cnt > 0) base = (int)atomicAdd(a.count + lane, (unsigned)cnt);
#pragma unroll
            for (int k = 0; k < 4; ++k) { const int p = __shfl(base, e[k]) + rank[k];
                if (act) { a.top_e[t * 4 + k] = e[k]; a.gates[t * 4 + k] = ex[k] * inv; a.pos[t * 4 + k] = p; } }
        }
        __syncthreads();
    }
}
__device__ __forceinline__ void fill_phase(const unsigned* count, const int* top_e, const int* pos, int* pstart_g, int* tile_e, int* slot_of_pair, const bf16_t* H2, bf16_t* XG,
                                           LAS unsigned char* lds, int tid, int lane, int gw, int ngw) {
    LAS int* ps = (LAS int*)lds;
    if (tid == 0) { int acc = 0; for (int e = 0; e < 32; ++e) { ps[e] = acc; acc += ((int)count[e] + 255) / 256 * 256; } ps[32] = acc; }
    __syncthreads();
    if (blockIdx.x == 0) { if (tid < 33) pstart_g[tid] = ps[tid];
        for (int rt = tid; rt < MAXTILES; rt += 512) { const int row = rt * 256; int e = 0; for (int i = 1; i < 32; ++i) if (row >= ps[i]) e = i; tile_e[rt] = e; } }
    for (int t = gw; t < T_TOK; t += ngw) {
        int slot = 0; if (lane < 4) { slot = ps[top_e[t * 4 + lane]] + pos[t * 4 + lane]; slot_of_pair[t * 4 + lane] = slot; }
        const u32x4 v0 = *(const u32x4*)(H2 + (size_t)t * DM + lane * 8), v1 = *(const u32x4*)(H2 + (size_t)t * DM + 512 + lane * 8);
#pragma unroll
        for (int k = 0; k < 4; ++k) { const int sk = __shfl(slot, k); bf16_t* d = XG + (size_t)sk * DM; *(u32x4*)(d + lane * 8) = v0; *(u32x4*)(d + 512 + lane * 8) = v1; }
    }
}
struct CombArgs { const bf16_t* YP; const int* slot_of_pair; const float* gates; const float* X1; const float* mvB; const float* lg; const float* lb; float* OUT;
                  const float* mvN; bf16_t* HB; const float* Wf; const float* fb; float* FL; };
__device__ __forceinline__ void combine_row(const CombArgs& a, int t, int lane) {
    const int b = t / SEQ;
    int sl[4]; float gk[4];
#pragma unroll
    for (int k = 0; k < 4; ++k) { sl[k] = a.slot_of_pair[t * 4 + k]; gk[k] = a.gates[t * 4 + k]; }
    const float* xr = a.X1 + (size_t)t * DM; const float* gB = a.mvB + b * 3072 + 2048;
    f32x4 v[4]; float s = 0.f;
#pragma unroll
    for (int j = 0; j < 4; ++j) { const int col = 4 * lane + 256 * j; f32x4 y = {0.f, 0.f, 0.f, 0.f};
#pragma unroll
        for (int k = 0; k < 4; ++k) { const u32x2 w = *(const u32x2*)(a.YP + (size_t)sl[k] * DM + col); y[0] += gk[k] * bflo(w.x); y[1] += gk[k] * bfhi(w.x); y[2] += gk[k] * bflo(w.y); y[3] += gk[k] * bfhi(w.y); }
        const f32x4 x = *(const f32x4*)(xr + col), g = *(const f32x4*)(gB + col);
        v[j] = DN_ALPHA * x + (1.f + g) * y; s += (v[j][0] + v[j][1]) + (v[j][2] + v[j][3]); }
    const float mean = wave_sum(s) * (1.f / DM); float s2 = 0.f;
#pragma unroll
    for (int j = 0; j < 4; ++j) { v[j] = v[j] - mean; s2 += (v[j][0] * v[j][0] + v[j][1] * v[j][1]) + (v[j][2] * v[j][2] + v[j][3] * v[j][3]); }
    const float rstd = 1.f / sqrtf(wave_sum(s2) * (1.f / DM) + LN_EPS);
    float fl[8] = {0.f, 0.f, 0.f, 0.f, 0.f, 0.f, 0.f, 0.f};
#pragma unroll
    for (int j = 0; j < 4; ++j) { const int col = 4 * lane + 256 * j; const f32x4 g = *(const f32x4*)(a.lg + col), bb = *(const f32x4*)(a.lb + col);
        const f32x4 x2 = v[j] * rstd * g + bb; *(f32x4*)(a.OUT + (size_t)t * DM + col) = x2;
        if (a.mvN) { const float* mN = a.mvN + b * 3072; const f32x4 sh = *(const f32x4*)(mN + col), sc = *(const f32x4*)(mN + 1024 + col); const f32x4 h = x2 * (1.f + sc) + sh;
            u32x2 w; w.x = pk2(h[0], h[1]); w.y = pk2(h[2], h[3]); *(u32x2*)(a.HB + (size_t)t * DM + col) = w;
#pragma unroll
            for (int hh = 0; hh < 8; ++hh) { const f32x4 wf = *(const f32x4*)(a.Wf + hh * 1024 + col); fl[hh] += (h[0] * wf[0] + h[1] * wf[1]) + (h[2] * wf[2] + h[3] * wf[3]); } } }
    if (a.mvN) {
        float mine = 0.f;
#pragma unroll
        for (int hh = 0; hh < 8; ++hh) { const float tot = wave_sum(fl[hh]); if (lane == hh) mine = tot; }
        if (lane < 8) { const float x = mine + a.fb[lane]; a.FL[t * 8 + lane] = fminf(x, 0.f) - log1pf(__expf(-fabsf(x))); }
    }
}
struct S5Par { float ar, ai, bbr[16], bbi[16]; };
__device__ __forceinline__ void s5_params(S5Par& P, int g, int p, const float* lam_re, const float* lam_im, const float* log_dt, const float* b_re, const float* b_im) {
    const float dt = expf(log_dt[g]); const float lre = fminf(lam_re[g * 64 + p], -1e-4f), lim = lam_im[g * 64 + p];
    const float mag = expf(lre * dt); P.ar = mag * cosf(lim * dt); P.ai = mag * sinf(lim * dt);
    const float den = lre * lre + lim * lim, nre = P.ar - 1.f, nim = P.ai;
    const float gre = (nre * lre + nim * lim) / den, gim = (nim * lre - nre * lim) / den;
#pragma unroll
    for (int c = 0; c < 16; ++c) { const float br = b_re[(g * 64 + p) * 16 + c], bi = b_im[(g * 64 + p) * 16 + c]; P.bbr[c] = gre * br - gim * bi; P.bbi[c] = gre * bi + gim * br; }
}
__device__ __forceinline__ void s5_load_u(const bf16_t* Z, size_t t, int g, float (&u)[16]) {
    const u32x4* up = (const u32x4*)(Z + t * ZP + g * 16); const u32x4 w0 = up[0], w1 = up[1];
    u[0] = bflo(w0.x); u[1] = bfhi(w0.x); u[2] = bflo(w0.y); u[3] = bfhi(w0.y); u[4] = bflo(w0.z); u[5] = bfhi(w0.z); u[6] = bflo(w0.w); u[7] = bfhi(w0.w);
    u[8] = bflo(w1.x); u[9] = bfhi(w1.x); u[10] = bflo(w1.y); u[11] = bfhi(w1.y); u[12] = bflo(w1.z); u[13] = bfhi(w1.z); u[14] = bflo(w1.w); u[15] = bfhi(w1.w);
}
__device__ __forceinline__ void s5_pass1(const bf16_t* Z, float* SLOC, int gw, int lane, const float* lam_re, const float* lam_im, const float* log_dt, const float* b_re, const float* b_im) {
    const int it0 = gw * 4, bg = it0 >> 7, c0 = it0 & 127, b = bg >> 5, g = bg & 31;
    S5Par P; s5_params(P, g, lane, lam_re, lam_im, log_dt, b_re, b_im);
#pragma unroll 1
    for (int q = 0; q < 4; ++q) { const int c = c0 + q; float xr = 0.f, xi = 0.f;
#pragma unroll 4
        for (int j = 0; j < 64; ++j) { float u[16]; s5_load_u(Z, (size_t)b * SEQ + c * 64 + j, g, u); float bur = 0.f, bui = 0.f;
#pragma unroll
            for (int cc = 0; cc < 16; ++cc) { bur += P.bbr[cc] * u[cc]; bui += P.bbi[cc] * u[cc]; }
            const float nxr = P.ar * xr - P.ai * xi + bur, nxi = P.ar * xi + P.ai * xr + bui; xr = nxr; xi = nxi; }
        *(f32x2*)(SLOC + ((size_t)(bg * 128 + c) * 64 + lane) * 2) = (f32x2){xr, xi}; }
}
__device__ __forceinline__ void s5_pass3(const bf16_t* Z, const float* SLOC, bf16_t* YG, int gw, int lane, LAS unsigned char* wlds  ,
                                         const float* lam_re, const float* lam_im, const float* log_dt, const float* b_re, const float* b_im, const float* c_re, const float* c_im, const float* d_skip) {
    const int it0 = gw * 4, bg = it0 >> 7, c0 = it0 & 127, b = bg >> 5, g = bg & 31;
    S5Par P; s5_params(P, g, lane, lam_re, lam_im, log_dt, b_re, b_im);
    float a64r = P.ar, a64i = P.ai;
#pragma unroll
    for (int i = 0; i < 6; ++i) { const float nr = a64r * a64r - a64i * a64i, ni = 2.f * a64r * a64i; a64r = nr; a64i = ni; }
    const int cc = lane & 15, part = lane >> 4;
    float cre[16], cim[16];
#pragma unroll
    for (int i = 0; i < 16; ++i) { cre[i] = c_re[(g * 16 + cc) * 64 + 16 * part + i]; cim[i] = c_im[(g * 16 + cc) * 64 + 16 * part + i]; }
    const float dsk = d_skip[g * 16 + cc];
    float xr = 0.f, xi = 0.f;
    { float pr = 1.f, pi = 0.f;
#pragma unroll 4
        for (int cp = c0 - 1; cp >= 0; --cp) { const f32x2 s = *(const f32x2*)(SLOC + ((size_t)(bg * 128 + cp) * 64 + lane) * 2);
            xr += pr * s.x - pi * s.y; xi += pr * s.y + pi * s.x; const float nr = pr * a64r - pi * a64i, ni = pr * a64i + pi * a64r; pr = nr; pi = ni; } }
    LAS float* XS = (LAS float*)wlds; LAS bf16_t* YO = (LAS bf16_t*)(wlds + 512);
#pragma unroll 1
    for (int q = 0; q < 4; ++q) { const int c = c0 + q;
#pragma unroll 2
        for (int j = 0; j < 64; ++j) { const size_t t = (size_t)b * SEQ + c * 64 + j; float u[16]; s5_load_u(Z, t, g, u); float bur = 0.f, bui = 0.f;
#pragma unroll
            for (int k = 0; k < 16; ++k) { bur += P.bbr[k] * u[k]; bui += P.bbi[k] * u[k]; }
            const float nxr = P.ar * xr - P.ai * xi + bur, nxi = P.ar * xi + P.ai * xr + bui; xr = nxr; xi = nxi;
            XS[lane] = xr; XS[64 + lane] = xi;
            float y = 0.f;
#pragma unroll
            for (int i4 = 0; i4 < 4; ++i4) { const f32x4 a = *(const LAS f32x4*)(XS + 16 * part + 4 * i4), bq = *(const LAS f32x4*)(XS + 64 + 16 * part + 4 * i4);
#pragma unroll
                for (int i = 0; i < 4; ++i) y += cre[4 * i4 + i] * a[i] - cim[4 * i4 + i] * bq[i]; }
            y += __shfl_xor(y, 16); y += __shfl_xor(y, 32);
            const float uc = bf2f(Z[t * ZP + g * 16 + cc]);
            y += dsk * uc;
            const float z2 = 1.5957691216057308f * (y + 0.044715f * y * y * y);
            const float ge = y * fast_sigmoid(z2);
            if (lane < 16) YO[j * 16 + lane] = (bf16_t)(pk2(ge, 0.f) & 0xffffu);
        }
        LDS_WAIT();
#pragma unroll
        for (int ps = 0; ps < 2; ++ps) { const int tok = (lane >> 1) + 32 * ps, half = lane & 1; const u32x4 v = *(const LAS u32x4*)(YO + tok * 16 + half * 8);
            *(u32x4*)(YG + ((size_t)b * SEQ + c * 64 + tok) * 512 + g * 16 + half * 8) = v; }
        LDS_WAIT();
    }
}
__device__ __forceinline__ void f2_scan(const float* FL, float* F2, int bh, int lane) {
    const int b = bh >> 3, h = bh & 7; const float* src = FL + ((size_t)b * SEQ + 128 * lane) * 8 + h;
    float loc = 0.f;
#pragma unroll 16
    for (int i = 0; i < 128; ++i) loc += src[i * 8];
    float inc = loc;
#pragma unroll
    for (int o = 1; o < 64; o <<= 1) { const float n = __shfl_up(inc, o); if (lane >= o) inc += n; }
    float run = inc - loc; float* dst = F2 + (size_t)bh * SEQ + 128 * lane;
#pragma unroll 16
    for (int i = 0; i < 128; ++i) { run += src[i * 8]; dst[i] = run * LOG2E; }
}
}
namespace cg = cooperative_groups;
constexpr size_t MiB = 1u << 20;
constexpr size_t WS_CTL = 0, CTL_BYTES = 1 * MiB;
constexpr size_t WS_MODV = 1 * MiB, WS_WF = 1 * MiB + 512 * 1024, WS_WRT = 1 * MiB + 768 * 1024;
constexpr size_t WS_WIN0 = 2 * MiB, WS_WOUT0 = 6 * MiB, WS_WIN1 = 8 * MiB, WS_WOUT1 = 12 * MiB, WS_WGLU = 14 * MiB, WS_INTS = 15 * MiB;
constexpr size_t WS_WGU = 16 * MiB, WS_WDN = 272 * MiB, WS_HB = 400 * MiB, WS_Z = 432 * MiB, WS_CAT = 496 * MiB, WS_Y = 528 * MiB, WS_X1 = 592 * MiB, WS_X2 = 656 * MiB, WS_H2 = 720 * MiB;
constexpr size_t WS_XG = 752 * MiB, WS_ACT = 896 * MiB, WS_ROUTE = 1040 * MiB, WS_FL = 1042 * MiB, WS_F2 = 1042 * MiB + 512 * 1024, WS_SLOC = 1044 * MiB, WS_YG = 1048 * MiB, WS_END = 1064 * MiB;
constexpr int CW_COUNT = 8192;
constexpr int LDS_BYTES = 147456;
constexpr int S5_LDS_OFF = 102400;
static_assert(att::L_END <= S5_LDS_OFF && S5_LDS_OFF + 8 * 2560 <= 131072, "LDS map");


struct Params { const float* in[30]; float* out; unsigned char* ws; };
#define KAS __attribute__((address_space(4)))
#define PH_BEGIN \
    const KAS Params* kp = (const KAS Params*)__builtin_amdgcn_kernarg_segment_ptr(); asm volatile("" : "+s"(kp)); \
    int tid = threadIdx.x; asm volatile("" : "+v"(tid)); const int lane = tid & 63; const int wid = __builtin_amdgcn_readfirstlane(tid >> 6); \
    int bx = blockIdx.x; asm volatile("" : "+s"(bx)); const int gw = bx * 8 + wid; constexpr int ngw = 2048, G = 256; (void)lane; (void)gw; (void)ngw; (void)G;
#define GSYNC() cg::this_grid().sync()
#define IN(i) (kp->in[i])
#define WSP(T, off) ((T*)(kp->ws + (off)))
#define x_in IN(0)
#define cvec IN(1)
#define mod_w IN(2)
#define mod_b IN(3)
#define ln_g IN(4)
#define ln_b IN(5)
#define even_w_in IN(6)
#define pool_w IN(7)
#define pool_scale IN(8)
#define rel_bias IN(9)
#define even_w_out IN(10)
#define odd_w_in IN(11)
#define forget_b IN(12)
#define lam_re IN(13)
#define lam_im IN(14)
#define log_dt IN(15)
#define b_re IN(16)
#define b_im IN(17)
#define c_re IN(18)
#define c_im IN(19)
#define d_skip IN(20)
#define glu_w IN(21)
#define glu_b IN(22)
#define odd_w_out IN(23)
#define router_w IN(24)
#define router_b IN(25)
#define exp_w_gu IN(26)
#define exp_b_gu IN(27)
#define exp_w_down IN(28)
#define exp_b_down IN(29)
#define ctl WSP(unsigned, WS_CTL)
#define MODV WSP(float, WS_MODV)
#define WF WSP(float, WS_WF)
#define WRT WSP(bf16_t, WS_WRT)
#define W_IN0 WSP(bf16_t, WS_WIN0)
#define W_OUT0 WSP(bf16_t, WS_WOUT0)
#define W_IN1 WSP(bf16_t, WS_WIN1)
#define W_OUT1 WSP(bf16_t, WS_WOUT1)
#define W_GLU WSP(bf16_t, WS_WGLU)
#define PSTART WSP(int, WS_INTS)
#define TILE_E (PSTART + 64)
#define W_GU WSP(bf16_t, WS_WGU)
#define W_DN WSP(bf16_t, WS_WDN)
#define HB WSP(bf16_t, WS_HB)
#define Z WSP(bf16_t, WS_Z)
#define CAT WSP(bf16_t, WS_CAT)
#define Y WSP(float, WS_Y)
#define X1 WSP(float, WS_X1)
#define X2 WSP(float, WS_X2)
#define H2 WSP(bf16_t, WS_H2)
#define XG WSP(bf16_t, WS_XG)
#define YP WSP(bf16_t, WS_XG)
#define ACT WSP(bf16_t, WS_ACT)
#define TOP_E WSP(int, WS_ROUTE)
#define GATES WSP(float, WS_ROUTE + 256 * 1024)
#define POS WSP(int, WS_ROUTE + 512 * 1024)
#define SLOT WSP(int, WS_ROUTE + 768 * 1024)
#define FL WSP(float, WS_FL)
#define F2 WSP(float, WS_F2)
#define SLOC WSP(float, WS_SLOC)
#define YG WSP(bf16_t, WS_YG)

template <int LAYER> __device__ __forceinline__ void layer_body(LAS unsigned char* lds) {
    { PH_BEGIN
      pg8::Gemm g{HB, LAYER ? W_IN1 : W_IN0, T_TOK, 2048, 1024}; pg8::StaticOrder S; S.init(T_TOK, 2048, G, bx); epi::EpiZ E{Z, ZP, 512, 1024, QSCALE};
      pg8::gemm_phase<epi::EpiZ, pg8::StaticOrder, true, true>(lds, g, S, E); }
    GSYNC();
    if (LAYER == 0) {
        { PH_BEGIN
          for (int t = gw; t < T_TOK; t += ngw) thin::pool_row(Z, t, CAT, lane); }
        { PH_BEGIN
          for (int ui = bx; ui < 512; ui += G) { const int bh = ui & 15, qb = ui >> 4, b = bh >> 3, h = bh & 7;
              if (tid < 257) ((LAS float*)(lds + att::L_TAB))[tid] = rel_bias[h * 257 + tid] * LOG2E;
              att::attn_unit<0>(b, h, qb, (4 * qb - 8 < 0) ? 0 : 4 * qb - 8, Z, CAT, nullptr, (LAS char*)lds); } }
    } else {
        { PH_BEGIN
          thin::s5_pass1(Z, SLOC, gw, lane, lam_re, lam_im, log_dt, b_re, b_im); }
        { PH_BEGIN
          if (gw < 16) thin::f2_scan(FL, F2, gw, lane); }
        GSYNC();
        { PH_BEGIN
          thin::s5_pass3(Z, SLOC, YG, gw, lane, lds + S5_LDS_OFF + wid * 2560, lam_re, lam_im, log_dt, b_re, b_im, c_re, c_im, d_skip); }
        { PH_BEGIN
          const int k = bx >> 4, bh = bx & 15, b = bh >> 3, h = bh & 7;
          att::attn_unit<1>(b, h, 31 - k, 0, Z, CAT, F2 + (size_t)bh * SEQ, (LAS char*)lds); }
        { PH_BEGIN
          const int k = bx >> 4, bh = bx & 15, b = bh >> 3, h = bh & 7;
          att::attn_unit<1>(b, h, k, 0, Z, CAT, F2 + (size_t)bh * SEQ, (LAS char*)lds); }
        GSYNC();
        { PH_BEGIN
          pg8::Gemm g{YG, W_GLU, T_TOK, 512, 512}; pg8::StaticOrder S; S.init(T_TOK, 512, G, bx); epi::EpiGlu E{CAT, YG, glu_b};
          pg8::gemm_phase<epi::EpiGlu, pg8::StaticOrder, true, true>(lds, g, S, E); }
    }
    GSYNC();
    { PH_BEGIN
      pg8::Gemm g{CAT, LAYER ? W_OUT1 : W_OUT0, T_TOK, 1024, 1024}; pg8::StaticOrder S; S.init(T_TOK, 1024, G, bx); epi::EpiF32 E{Y, 1024};
      pg8::gemm_phase<epi::EpiF32, pg8::StaticOrder, true, true>(lds, g, S, E); }
    GSYNC();
    { PH_BEGIN
      thin::LnrArgs a{LAYER ? X2 : x_in, Y, MODV + (LAYER * 2 + 0) * 2 * 3072, MODV + (LAYER * 2 + 1) * 2 * 3072, ln_g + (LAYER * 2 + 0) * 1024, ln_b + (LAYER * 2 + 0) * 1024, X1, H2,
                      WRT + LAYER * 32768, router_b + LAYER * 32, ctl + CW_COUNT + LAYER * 64, TOP_E, GATES, POS};
      thin::lnr_phase(a, lds, tid, lane, wid); }
    GSYNC();
    { PH_BEGIN
      thin::fill_phase(ctl + CW_COUNT + LAYER * 64, TOP_E, POS, PSTART, TILE_E, SLOT, H2, XG, lds, tid, lane, gw, ngw); }
    GSYNC();
    { PH_BEGIN
      const int R = PSTART[32] >> 8;
      pg8::Gemm g{XG, W_GU + (size_t)LAYER * 32 * 2097152, MAXROWS, 2048, 1024}; epi::MoeOrder S{R, 8, bx, TILE_E, (size_t)2097152 * 2}; epi::EpiSwiglu E{ACT, exp_b_gu + (size_t)LAYER * 32 * 2048};
      pg8::gemm_phase<epi::EpiSwiglu, epi::MoeOrder, true, true>(lds, g, S, E); }
    GSYNC();
    { PH_BEGIN
      const int R = PSTART[32] >> 8;
      pg8::Gemm g{ACT, W_DN + (size_t)LAYER * 32 * 1048576, MAXROWS, 1024, 1024}; epi::MoeOrder S{R, 4, bx, TILE_E, (size_t)1048576 * 2}; epi::EpiBiasBf16 E{YP, exp_b_down + (size_t)LAYER * 32 * 1024};
      pg8::gemm_phase<epi::EpiBiasBf16, epi::MoeOrder, true, true>(lds, g, S, E); }
    GSYNC();
    { PH_BEGIN
      thin::CombArgs a{YP, SLOT, GATES, X1, MODV + (LAYER * 2 + 1) * 2 * 3072, ln_g + (LAYER * 2 + 1) * 1024, ln_b + (LAYER * 2 + 1) * 1024, LAYER ? kp->out : X2,
                       LAYER ? nullptr : MODV + 2 * 2 * 3072, HB, WF, forget_b, FL};
      for (int t = gw; t < T_TOK; t += ngw) thin::combine_row(a, t, lane); }
}

__global__ void __launch_bounds__(512, 2) mega_fwd(Params p_unused) {
    extern __shared__ __attribute__((aligned(16))) unsigned char lds_raw[];
    LAS unsigned char* lds = (LAS unsigned char*)lds_raw;
    { PH_BEGIN
      thin::ada_mod(cvec, mod_w, mod_b, MODV, lds, tid, lane, wid); }
    __syncthreads();
    { PH_BEGIN
      LAS float* scr = (LAS float*)(lds + wid * 8448);
      for (int it = gw; it < 3968; it += ngw) { int r = it;
        if (r < 1024) { thin::tr_matrix_item(even_w_in, 2048, 2048, r, W_IN0, 1024, 0, scr, lane); continue; } r -= 1024;
        if (r < 256) { thin::tr_matrix_item(even_w_out + 512 * 1024, 1024, 1024, r, W_OUT0, 1024, 512, scr, lane); continue; } r -= 256;
        if (r < 1024) { thin::tr_matrix_item(odd_w_in, 2056, 2048, r, W_IN1, 1024, 0, scr, lane); continue; } r -= 1024;
        if (r < 512) { thin::tr_matrix_item(odd_w_out, 1024, 1024, r, W_OUT1, 1024, 0, scr, lane); continue; } r -= 512;
        if (r < 128) { thin::tr_matrix_item(glu_w, 512, 512, r, W_GLU, 512, 0, scr, lane); continue; } r -= 128;
        thin::fold_item(pool_w, pool_scale, even_w_out, r, W_OUT0, lane); }
      for (int idx = gw * 64 + lane; idx < 8192; idx += ngw * 64) WF[idx] = odd_w_in[(size_t)(idx & 1023) * 2056 + 2048 + (idx >> 10)];
      for (int idx = gw * 64 + lane; idx < 65536; idx += ngw * 64) { const int layer = idx >> 15, r = idx & 32767, e = r >> 10, k = r & 1023; WRT[idx] = (bf16_t)(pk2(router_w[layer * 32768 + k * 32 + e], 0.f) & 0xffffu); } }
    GSYNC();
    { PH_BEGIN
      for (int t = gw; t < T_TOK; t += ngw) thin::mod_row(x_in + (size_t)t * DM, MODV + (0 * 2 + t / SEQ) * 3072, HB + (size_t)t * DM, lane); }
    { PH_BEGIN
      LAS float* scr = (LAS float*)(lds + wid * 8448);
      for (int it = gw; it < 98304; it += ngw) {
        if (it < 65536) { const int le = it >> 10, r = it & 1023; thin::tr_gu_item(exp_w_gu + (size_t)le * 2097152, r, W_GU + (size_t)le * 2097152, scr, lane); }
        else { const int r0 = it - 65536, le = r0 >> 9, r = r0 & 511; thin::tr_matrix_item(exp_w_down + (size_t)le * 1048576, 1024, 1024, r, W_DN + (size_t)le * 1048576, 1024, 0, scr, lane); } } }
    GSYNC();
    layer_body<0>(lds);
    GSYNC();
    layer_body<1>(lds);
}
#undef PH_BEGIN
#undef GSYNC
#undef IN
#undef WSP
#undef x_in
#undef cvec
#undef mod_w
#undef mod_b
#undef ln_g
#undef ln_b
#undef even_w_in
#undef pool_w
#undef pool_scale
#undef rel_bias
#undef even_w_out
#undef odd_w_in
#undef forget_b
#undef lam_re
#undef lam_im
#undef log_dt
#undef b_re
#undef b_im
#undef c_re
#undef c_im
#undef d_skip
#undef glu_w
#undef glu_b
#undef odd_w_out
#undef router_w
#undef router_b
#undef exp_w_gu
#undef exp_b_gu
#undef exp_w_down
#undef exp_b_down
#undef ctl
#undef MODV
#undef WF
#undef WRT
#undef W_IN0
#undef W_OUT0
#undef W_IN1
#undef W_OUT1
#undef W_GLU
#undef PSTART
#undef TILE_E
#undef W_GU
#undef W_DN
#undef HB
#undef Z
#undef CAT
#undef Y
#undef X1
#undef X2
#undef H2
#undef XG
#undef YP
#undef ACT
#undef TOP_E
#undef GATES
#undef POS
#undef SLOT
#undef FL
#undef F2
#undef SLOC
#undef YG
static bool launch_mega(void* const* d_in, void* d_out, void* d_ws, size_t ws_size, hipStream_t stream) {
    static int grid = 0;
    if (grid == 0) {
        int dev = 0, cus = 0, per_cu = 0;
        if (ws_size < WS_END) { fprintf(stderr, "kernel_launch: workspace too small (%zu < %zu)\n", ws_size, (size_t)WS_END); grid = -1; return false; }
        if (hipGetDevice(&dev) != hipSuccess || hipDeviceGetAttribute(&cus, hipDeviceAttributeMultiprocessorCount, dev) != hipSuccess) { grid = -1; return false; }
        if (hipFuncSetAttribute((const void*)mega_fwd, hipFuncAttributeMaxDynamicSharedMemorySize, LDS_BYTES) != hipSuccess) { fprintf(stderr, "kernel_launch: hipFuncSetAttribute failed\n"); grid = -1; return false; }
        if (hipOccupancyMaxActiveBlocksPerMultiprocessor(&per_cu, (const void*)mega_fwd, 512, LDS_BYTES) != hipSuccess || per_cu < 1) { fprintf(stderr, "kernel_launch: occupancy query says %d blocks per CU\n", per_cu); grid = -1; return false; }
        (void)hipGetLastError();
        grid = cus;
        if (grid != 256) { fprintf(stderr, "kernel_launch: built for a 256-CU device, found %d CUs\n", cus); grid = -1; return false; }
    }
    if (grid < 0) return false;
    (void)hipMemsetAsync((char*)d_ws + WS_CTL, 0, CTL_BYTES, stream);
    Params p{};
    for (int i = 0; i < 30; ++i) p.in[i] = (const float*)d_in[i];
    p.out = (float*)d_out; p.ws = (unsigned char*)d_ws;
    void* args[] = {&p};
    hipError_t e = hipLaunchCooperativeKernel((const void*)mega_fwd, dim3(grid), dim3(512), args, LDS_BYTES, stream);
    if (e != hipSuccess) { fprintf(stderr, "cooperative launch failed: %s (grid %d)\n", hipGetErrorString(e), grid); return false; }
    return true;
}
extern "C" void kernel_launch(void* const* d_in, const int* in_sizes, int n_in, void* d_out, int out_size, void* d_ws, size_t ws_size, hipStream_t stream) {
    launch_mega(d_in, d_out, d_ws, ws_size, stream);
}
```

```cpp
#include <hip/hip_runtime.h>
#include <hip/hip_cooperative_groups.h>
#include <cstdio>
#include <cstdint>
#include <cstring>
#include <cmath>
#define LAS __attribute__((address_space(3)))
#define GAS __attribute__((address_space(1)))
typedef unsigned short bf16_t;
typedef short bf16x8 __attribute__((ext_vector_type(8)));
typedef short s16x4 __attribute__((ext_vector_type(4)));
typedef float f32x4 __attribute__((ext_vector_type(4)));
typedef float f32x2 __attribute__((ext_vector_type(2)));
typedef float f32x16 __attribute__((ext_vector_type(16)));
typedef unsigned u32x4 __attribute__((ext_vector_type(4)));
typedef unsigned u32x2 __attribute__((ext_vector_type(2)));
typedef __bf16 bf16x2_t __attribute__((ext_vector_type(2)));

constexpr int T_TOK = 16384, SEQ = 8192, DM = 1024, NBATCH = 2;
constexpr int ZP = 2048;
constexpr int MAXROWS = 73728;
constexpr int MAXTILES = MAXROWS / 256;
constexpr float DN_ALPHA = 1.41421356237309515f;
constexpr float LN_EPS = 1e-5f;
constexpr float LOG2E = 1.4426950408889634f;
constexpr float QSCALE = 0.125f * 1.4426950408889634f;

__device__ __forceinline__ unsigned pk2(float lo, float hi) { f32x2 v = {lo, hi}; bf16x2_t b = __builtin_convertvector(v, bf16x2_t); return __builtin_bit_cast(unsigned, b); }
__device__ __forceinline__ float bf2f(unsigned short u) { return __uint_as_float(((unsigned)u) << 16); }
__device__ __forceinline__ float bflo(unsigned w) { return __uint_as_float(w << 16); }
__device__ __forceinline__ float bfhi(unsigned w) { return __uint_as_float(w & 0xffff0000u); }
__device__ __forceinline__ float wave_sum(float v) {
#pragma unroll
    for (int o = 1; o < 64; o <<= 1) v += __shfl_xor(v, o);
    return v;
}
__device__ __forceinline__ float fast_sigmoid(float x) { return __builtin_amdgcn_rcpf(1.f + __builtin_amdgcn_exp2f(-x * LOG2E)); }
#define LDS_WAIT() asm volatile("s_waitcnt lgkmcnt(0)" ::: "memory")
#define VM_WAIT() asm volatile("s_waitcnt vmcnt(0)" ::: "memory")
namespace pg8 {
#define PG8_LAS __attribute__((address_space(3)))
typedef unsigned short bf16_t;
typedef short bf16x8 __attribute__((ext_vector_type(8)));
typedef float f32x4 __attribute__((ext_vector_type(4)));
typedef unsigned u32x4 __attribute__((ext_vector_type(4)));
constexpr int BM = 256, BK = 64, HALF = 128, HTB = HALF * BK * 2  , STAGE_BYTES = 8 * HTB, NXCD = 8, WGM = 8;

__host__ __device__ __forceinline__ int lds_byte(int r, int c) { const int st = (r >> 4) * 2 + (c >> 5), rr = r & 15, cc = c & 31, ob = rr * 64 + cc * 2; return st * 1024 + (ob ^ (((ob >> 9) & 1) << 5)); }
__host__ __device__ __forceinline__ void stage_rc(int b, int& R, int& C) { const int st = b / 1024, sb = b % 1024, swz = sb ^ (((sb >> 9) & 1) << 5); R = (st >> 1) * 16 + swz / 64; C = (st & 1) * 32 + (swz % 64) / 2; }
__host__ __device__ __forceinline__ int perm32(int rho) { const int n = rho >> 4, i = rho & 15; return 8 * (i >> 2) + 4 * n + (i & 3); }

struct Unit { int pm, pn, e; size_t boff; };
struct Gemm { const bf16_t* A; const bf16_t* Bt; int M, N, K; };

struct StaticOrder {
    int nM, nN, nwg, G, c;
    __host__ __device__ void init(int M, int N, int G_, int c_) { nM = M / BM; nN = N / BM; nwg = nM * nN; G = G_; c = c_; }
    __host__ __device__ bool next(int i, Unit& u) const {
        const long L = (long)i * G + c; if (L >= nwg) return false;
        int wgid = (int)L; { const int q = nwg / NXCD, r = nwg % NXCD, xcd = wgid % NXCD, off = wgid / NXCD; wgid = (xcd < r ? xcd * (q + 1) : r * (q + 1) + (xcd - r) * q) + off; }
        const int nig = WGM * nN, gid = wgid / nig, fm = gid * WGM, gsz = (nM - fm) < WGM ? (nM - fm) : WGM;
        u.pm = fm + ((wgid % nig) % gsz); u.pn = (wgid % nig) / gsz; u.e = 0; u.boff = 0; return true;
    }
    __device__ __forceinline__ void a_ready(const Unit&) const {}
    __device__ __forceinline__ void done(const Unit&) const {}
};

__device__ __forceinline__ unsigned cvt_pk_bf16(float lo, float hi) { unsigned r; asm volatile("v_cvt_pk_bf16_f32 %0, %1, %2" : "=v"(r) : "v"(lo), "v"(hi)); return r; }
typedef float f32x2 __attribute__((ext_vector_type(2)));

template <class Epi, class Sched, bool ALIGN_EPI = false, bool SP2 = false>
__device__ __forceinline__ void gemm_phase(PG8_LAS unsigned char* lds, const Gemm g, const Sched& S, const Epi& E) {
    const int tid = threadIdx.x, wid = __builtin_amdgcn_readfirstlane(tid >> 6), lane = tid & 63, wr = wid >> 2, wc = wid & 3, fr = lane & 15, fq = lane >> 4;
    const int K = g.K, nt = K / BK;
    unsigned voffA[2], voffB[2];
#pragma unroll
    for (int i = 0; i < 2; ++i) { int R, C; stage_rc(tid * 16 + i * 8192, R, C); const int Rb = Epi::PERM ? ((R & ~31) + perm32(R & 31)) : R;
        voffA[i] = (unsigned)(R * K + C) * 2u; voffB[i] = (unsigned)(Rb * K + C) * 2u; }
    const size_t kstep = (size_t)(BK * 2);
    const size_t hstep = (size_t)HALF * K * 2;
    const size_t tstep = 2 * hstep;
    const unsigned ldsw = (unsigned)wid * 1024u;
    const int aoff = lds_byte(wr * 64 + fr, fq * 8), boff = lds_byte(wc * 32 + fr, fq * 8);
#define PG8_SA(b, h) (((b) * 2 + (h)) * HTB)
#define PG8_SB(b, h) ((4 + (b) * 2 + (h)) * HTB)
#define PG8_STAGE(bufoff, gbase, voff) do { _Pragma("unroll") for (int _i = 0; _i < 2; ++_i) \
        __builtin_amdgcn_global_load_lds((const unsigned*)((const char*)(gbase) + (voff)[_i]), (PG8_LAS unsigned*)(lds + (bufoff) + ldsw + _i * 8192), 16, 0, 0); } while (0)
#define PG8_LDA(dst, b, h) do { _Pragma("unroll") for (int m = 0; m < 4; ++m) _Pragma("unroll") for (int k = 0; k < 2; ++k) dst[m][k] = *(const PG8_LAS bf16x8*)(lds + PG8_SA(b, h) + aoff + m * 2048 + k * 1024); } while (0)
#define PG8_LDB(dst, b, h) do { _Pragma("unroll") for (int n = 0; n < 2; ++n) _Pragma("unroll") for (int k = 0; k < 2; ++k) dst[n][k] = *(const PG8_LAS bf16x8*)(lds + PG8_SB(b, h) + boff + n * 2048 + k * 1024); } while (0)
#define PG8_MMA(ai, bj, At, Bt) do { __builtin_amdgcn_s_setprio(1); _Pragma("unroll") for (int m = 0; m < 4; ++m) _Pragma("unroll") for (int n = 0; n < 2; ++n) _Pragma("unroll") for (int k = 0; k < 2; ++k) \
        acc[ai][bj][m][n] = __builtin_amdgcn_mfma_f32_16x16x32_bf16(Bt[n][k], At[m][k], acc[ai][bj][m][n], 0, 0, 0); __builtin_amdgcn_s_setprio(0); } while (0)
#define PG8_WAIT_V(n) asm volatile("s_waitcnt vmcnt(" #n ")" ::: "memory")
#define PG8_WAIT_L(n) asm volatile("s_waitcnt lgkmcnt(" #n ")" ::: "memory")
#define PG8_BAR __builtin_amdgcn_s_barrier()
#define PG8_SCHED __builtin_amdgcn_sched_barrier(0)
    Unit cur, nxt; int ui = 0;
    if (!S.next(0, cur)) return;
    f32x4 acc[2][2][4][2];
#pragma unroll
    for (int a = 0; a < 2; ++a)
#pragma unroll
        for (int b = 0; b < 2; ++b)
#pragma unroll
            for (int m = 0; m < 4; ++m)
#pragma unroll
                for (int n = 0; n < 2; ++n) acc[a][b][m][n] = (f32x4){0.f, 0.f, 0.f, 0.f};
    bf16x8 At[4][2], B0[2][2], B1[2][2];
    const char* cA = (const char*)g.A + (size_t)cur.pm * tstep; const char* cB = (const char*)g.Bt + cur.boff + (size_t)cur.pn * tstep;
    S.a_ready(cur);
    if constexpr (SP2) {
        PG8_STAGE(PG8_SB(0, 0), cB, voffB); PG8_STAGE(PG8_SB(0, 1), cB + hstep, voffB); PG8_STAGE(PG8_SA(0, 0), cA, voffA); PG8_STAGE(PG8_SA(0, 1), cA + hstep, voffA);
        if (wr == 1) PG8_BAR;
        PG8_WAIT_V(2); PG8_BAR;
        PG8_STAGE(PG8_SB(1, 0), cB + kstep, voffB); PG8_STAGE(PG8_SA(1, 0), cA + kstep, voffA); PG8_STAGE(PG8_SB(1, 1), cB + hstep + kstep, voffB);
        PG8_WAIT_V(6); PG8_BAR;
    } else {
        PG8_STAGE(PG8_SB(0, 0), cB, voffB); PG8_STAGE(PG8_SA(0, 0), cA, voffA); PG8_STAGE(PG8_SB(0, 1), cB + hstep, voffB); PG8_STAGE(PG8_SA(0, 1), cA + hstep, voffA);
        if (wr == 1) PG8_BAR;
        PG8_WAIT_V(4); PG8_BAR;
        PG8_STAGE(PG8_SB(1, 0), cB + kstep, voffB); PG8_STAGE(PG8_SA(1, 0), cA + kstep, voffA); PG8_STAGE(PG8_SB(1, 1), cB + hstep + kstep, voffB);
        PG8_WAIT_V(6); PG8_BAR;
    }
    for (;;) {
        const bool has_next = S.next(ui + 1, nxt);
        const char* nA = has_next ? (const char*)g.A + (size_t)nxt.pm * tstep : cA; const char* nB = has_next ? (const char*)g.Bt + nxt.boff + (size_t)nxt.pn * tstep : cB;
        for (int t = 0; t < nt; t += 2) {
            const bool last = (t == nt - 2);
            const char* a1 = cA + (size_t)(t + 1) * kstep;
            const char* a2 = last ? nA : cA + (size_t)(t + 2) * kstep; const char* b2 = last ? nB : cB + (size_t)(t + 2) * kstep;
            const char* a3 = a2 + kstep; const char* b3 = b2 + kstep;
            if (last && has_next) S.a_ready(nxt);
            if constexpr (SP2) {
            PG8_LDB(B0, 0, 0); PG8_LDB(B1, 0, 1); PG8_SCHED; PG8_LDA(At, 0, 0); PG8_STAGE(PG8_SA(1, 1), a1 + hstep, voffA);
            PG8_WAIT_V(8); PG8_WAIT_L(0); PG8_BAR; PG8_MMA(0, 0, At, B0); PG8_MMA(0, 1, At, B1); PG8_BAR; PG8_SCHED;
            PG8_LDA(At, 0, 1); PG8_STAGE(PG8_SB(0, 0), b2, voffB); PG8_STAGE(PG8_SB(0, 1), b2 + hstep, voffB); PG8_STAGE(PG8_SA(0, 0), a2, voffA);
            PG8_WAIT_V(8); PG8_WAIT_L(0); PG8_BAR; PG8_MMA(1, 0, At, B0); PG8_MMA(1, 1, At, B1); PG8_BAR; PG8_SCHED;
            PG8_LDB(B0, 1, 0); PG8_LDB(B1, 1, 1); PG8_SCHED; PG8_LDA(At, 1, 0); PG8_STAGE(PG8_SA(0, 1), a2 + hstep, voffA);
            PG8_WAIT_V(8); PG8_WAIT_L(0); PG8_BAR; PG8_MMA(0, 0, At, B0); PG8_MMA(0, 1, At, B1); PG8_BAR; PG8_SCHED;
            PG8_LDA(At, 1, 1); PG8_STAGE(PG8_SB(1, 0), b3, voffB); PG8_STAGE(PG8_SB(1, 1), b3 + hstep, voffB); PG8_STAGE(PG8_SA(1, 0), a3, voffA);
            PG8_WAIT_V(8); PG8_WAIT_L(0); PG8_BAR; PG8_MMA(1, 0, At, B0); PG8_MMA(1, 1, At, B1); PG8_BAR; PG8_SCHED;
            } else {
            PG8_LDB(B0, 0, 0); PG8_SCHED; PG8_LDA(At, 0, 0); PG8_STAGE(PG8_SA(1, 1), a1 + hstep, voffA);
            PG8_WAIT_L(8); PG8_BAR; PG8_WAIT_L(0); PG8_MMA(0, 0, At, B0); PG8_BAR; PG8_SCHED;
            PG8_LDB(B1, 0, 1); PG8_STAGE(PG8_SB(0, 0), b2, voffB);
            PG8_BAR; PG8_WAIT_L(0); PG8_MMA(0, 1, At, B1); PG8_BAR;
            PG8_LDA(At, 0, 1); PG8_STAGE(PG8_SA(0, 0), a2, voffA);
            PG8_BAR; PG8_WAIT_L(0); PG8_MMA(1, 0, At, B0); PG8_BAR; PG8_SCHED;
            PG8_STAGE(PG8_SB(0, 1), b2 + hstep, voffB);
            PG8_WAIT_V(6); PG8_BAR; PG8_MMA(1, 1, At, B1); PG8_BAR;
            PG8_LDB(B0, 1, 0); PG8_SCHED; PG8_LDA(At, 1, 0); PG8_STAGE(PG8_SA(0, 1), a2 + hstep, voffA);
            PG8_WAIT_L(8); PG8_BAR; PG8_WAIT_L(0); PG8_MMA(0, 0, At, B0); PG8_BAR; PG8_SCHED;
            PG8_LDB(B1, 1, 1); PG8_STAGE(PG8_SB(1, 0), b3, voffB);
            PG8_BAR; PG8_WAIT_L(0); PG8_MMA(0, 1, At, B1); PG8_BAR;
            PG8_LDA(At, 1, 1); PG8_STAGE(PG8_SA(1, 0), a3, voffA);
            PG8_BAR; PG8_WAIT_L(0); PG8_MMA(1, 0, At, B0); PG8_BAR; PG8_SCHED;
            PG8_STAGE(PG8_SB(1, 1), b3 + hstep, voffB);
            PG8_WAIT_V(6); PG8_BAR; PG8_MMA(1, 1, At, B1); PG8_BAR;
            }
        }
        if constexpr (ALIGN_EPI) { if (wr == 0) PG8_BAR; }
        if constexpr (!Epi::AFTER_DRAIN) { E(acc, cur, wr, wc, fr, fq); S.done(cur); }
        if (!has_next) break;
#pragma unroll
        for (int a = 0; a < 2; ++a)
#pragma unroll
            for (int b = 0; b < 2; ++b)
#pragma unroll
                for (int m = 0; m < 4; ++m)
#pragma unroll
                    for (int n = 0; n < 2; ++n) acc[a][b][m][n] = (f32x4){0.f, 0.f, 0.f, 0.f};
        cur = nxt; cA = nA; cB = nB; ++ui;
        if constexpr (ALIGN_EPI) { if (wr == 1) PG8_BAR; }
    }
    PG8_WAIT_V(0);
    if constexpr (!ALIGN_EPI) { if (wr == 0) PG8_BAR; }
    PG8_BAR;
    if constexpr (Epi::AFTER_DRAIN) { E.fused(acc, cur, wr, wc, fr, fq, lds, wid, lane); S.done(cur); }
#undef PG8_SA
#undef PG8_SB
#undef PG8_STAGE
#undef PG8_LDA
#undef PG8_LDB
#undef PG8_MMA
#undef PG8_WAIT_V
#undef PG8_WAIT_L
#undef PG8_BAR
#undef PG8_SCHED
}
}

#ifndef PG8_SP2
#define PG8_SP2 true
#endif
#ifndef PG8_ALIGN
#define PG8_ALIGN true
#endif
namespace epi {
using pg8::Unit; using pg8::BM; using pg8::HALF;

struct EpiZ {
    static constexpr bool PERM = true, AFTER_DRAIN = false;
    bf16_t* O; int ldc; int sc_lo, sc_hi; float sc;
    __device__ __forceinline__ void operator()(const f32x4 (&acc)[2][2][4][2], const Unit& u, int wr, int wc, int fr, int fq) const {
        const int row0 = u.pm * BM + wr * 64 + fr; const int colt = u.pn * BM;
        const float s = (colt >= sc_lo && colt < sc_hi) ? sc : 1.f;
        const int col0 = colt + wc * 32 + 8 * fq;
#pragma unroll
        for (int ai = 0; ai < 2; ++ai)
#pragma unroll
            for (int m = 0; m < 4; ++m) { bf16_t* rowp = O + (size_t)(row0 + ai * HALF + m * 16) * ldc + col0;
#pragma unroll
                for (int bj = 0; bj < 2; ++bj) { const f32x4 v0 = acc[ai][bj][m][0] * s, v1 = acc[ai][bj][m][1] * s;
                    u32x4 w; w.x = pk2(v0[0], v0[1]); w.y = pk2(v0[2], v0[3]); w.z = pk2(v1[0], v1[1]); w.w = pk2(v1[2], v1[3]);
                    *(u32x4*)(rowp + bj * HALF) = w; } }
    }
};
struct EpiF32 {
    static constexpr bool PERM = false, AFTER_DRAIN = false;
    float* O; int ldc;
    __device__ __forceinline__ void operator()(const f32x4 (&acc)[2][2][4][2], const Unit& u, int wr, int wc, int fr, int fq) const {
        const int row0 = u.pm * BM + wr * 64 + fr; const int col0 = u.pn * BM + wc * 32 + 4 * fq;
#pragma unroll
        for (int ai = 0; ai < 2; ++ai)
#pragma unroll
            for (int m = 0; m < 4; ++m) { float* rowp = O + (size_t)(row0 + ai * HALF + m * 16) * ldc + col0;
#pragma unroll
                for (int bj = 0; bj < 2; ++bj)
#pragma unroll
                    for (int n = 0; n < 2; ++n) *(f32x4*)(rowp + bj * HALF + n * 16) = acc[ai][bj][m][n]; }
    }
};
struct EpiSwiglu {
    static constexpr bool PERM = true, AFTER_DRAIN = false;
    bf16_t* O; const float* bias;
    __device__ __forceinline__ void operator()(const f32x4 (&acc)[2][2][4][2], const Unit& u, int wr, int wc, int fr, int fq) const {
        const int row0 = u.pm * BM + wr * 64 + fr; const int cc = u.pn * 128 + wc * 32 + 8 * fq;
        const float* bg = bias + (size_t)u.e * 2048 + cc; const float* bu = bg + 1024;
        const f32x4 bg0 = *(const f32x4*)bg, bg1 = *(const f32x4*)(bg + 4), bu0 = *(const f32x4*)bu, bu1 = *(const f32x4*)(bu + 4);
#pragma unroll
        for (int ai = 0; ai < 2; ++ai)
#pragma unroll
            for (int m = 0; m < 4; ++m) {
                float r[8];
#pragma unroll
                for (int n = 0; n < 2; ++n) { const f32x4 g4 = acc[ai][0][m][n] + (n ? bg1 : bg0), u4 = acc[ai][1][m][n] + (n ? bu1 : bu0);
#pragma unroll
                    for (int i = 0; i < 4; ++i) { const float gate = fminf(g4[i], 7.0f); const float up = fminf(fmaxf(u4[i], -7.0f), 7.0f);
                        const float glu = gate * __builtin_amdgcn_rcpf(1.f + __builtin_amdgcn_exp2f(-1.702f * LOG2E * gate)); r[n * 4 + i] = (up + 1.0f) * glu; } }
                u32x4 w; w.x = pk2(r[0], r[1]); w.y = pk2(r[2], r[3]); w.z = pk2(r[4], r[5]); w.w = pk2(r[6], r[7]);
                *(u32x4*)(O + (size_t)(row0 + ai * HALF + m * 16) * 1024 + cc) = w; }
    }
};
struct EpiBiasBf16 {
    static constexpr bool PERM = true, AFTER_DRAIN = false;
    bf16_t* O; const float* bias;
    __device__ __forceinline__ void operator()(const f32x4 (&acc)[2][2][4][2], const Unit& u, int wr, int wc, int fr, int fq) const {
        const int row0 = u.pm * BM + wr * 64 + fr; const int col0 = u.pn * BM + wc * 32 + 8 * fq;
        const float* bp = bias + (size_t)u.e * 1024 + col0;
#pragma unroll
        for (int bj = 0; bj < 2; ++bj) { const f32x4 b0 = *(const f32x4*)(bp + bj * HALF), b1 = *(const f32x4*)(bp + bj * HALF + 4);
#pragma unroll
            for (int ai = 0; ai < 2; ++ai)
#pragma unroll
                for (int m = 0; m < 4; ++m) { const f32x4 v0 = acc[ai][bj][m][0] + b0, v1 = acc[ai][bj][m][1] + b1;
                    u32x4 w; w.x = pk2(v0[0], v0[1]); w.y = pk2(v0[2], v0[3]); w.z = pk2(v1[0], v1[1]); w.w = pk2(v1[2], v1[3]);
                    *(u32x4*)(O + (size_t)(row0 + ai * HALF + m * 16) * 1024 + col0 + bj * HALF) = w; } }
    }
};
struct EpiGlu {
    static constexpr bool PERM = true, AFTER_DRAIN = false;
    bf16_t* O; const bf16_t* YG; const float* bias;
    __device__ __forceinline__ void operator()(const f32x4 (&acc)[2][2][4][2], const Unit& u, int wr, int wc, int fr, int fq) const {
        const int row0 = u.pm * BM + wr * 64 + fr; const int col0 = u.pn * BM + wc * 32 + 8 * fq;
#pragma unroll
        for (int bj = 0; bj < 2; ++bj) { const f32x4 b0 = *(const f32x4*)(bias + col0 + bj * HALF), b1 = *(const f32x4*)(bias + col0 + bj * HALF + 4);
#pragma unroll
            for (int ai = 0; ai < 2; ++ai)
#pragma unroll
                for (int m = 0; m < 4; ++m) { const size_t row = (size_t)(row0 + ai * HALF + m * 16);
                    const u32x4 y = *(const u32x4*)(YG + row * 512 + col0 + bj * HALF);
                    const f32x4 v0 = acc[ai][bj][m][0] + b0, v1 = acc[ai][bj][m][1] + b1;
                    u32x4 w;
                    w.x = pk2(bflo(y.x) * fast_sigmoid(v0[0]), bfhi(y.x) * fast_sigmoid(v0[1])); w.y = pk2(bflo(y.y) * fast_sigmoid(v0[2]), bfhi(y.y) * fast_sigmoid(v0[3]));
                    w.z = pk2(bflo(y.z) * fast_sigmoid(v1[0]), bfhi(y.z) * fast_sigmoid(v1[1])); w.w = pk2(bflo(y.w) * fast_sigmoid(v1[2]), bfhi(y.w) * fast_sigmoid(v1[3]));
                    *(u32x4*)(O + row * 1024 + col0 + bj * HALF) = w; } }
    }
};
struct MoeOrder {
    int R, ncol, c; const int* tile_e; size_t estride;
    __device__ bool next(int i, Unit& u) const {
        const int xcd = c & 7, j = c >> 3, rp = 32 / ncol;
        const int rt = (i * 8 + xcd) * rp + j / ncol; if (rt >= R) return false;
        u.pm = rt; u.pn = j % ncol; u.e = tile_e[rt]; u.boff = (size_t)u.e * estride; return true;
    }
    __device__ __forceinline__ void a_ready(const Unit&) const {}
    __device__ __forceinline__ void done(const Unit&) const {}
};
}
namespace att {
constexpr int SLOTB = 8192;
constexpr int L_K = 0, L_V = 2 * SLOTB, L_WS = 4 * SLOTB, L_OST = L_WS + 8 * 64 * 4, L_FK = L_OST + 8 * 4096, L_TAB = L_FK + 8192 * 4, L_END = L_TAB + 272 * 4;
__device__ __forceinline__ int crow(int r, int hi) { return (r & 3) + 8 * (r >> 2) + 4 * hi; }
#define SBAR() __builtin_amdgcn_sched_barrier(0)
__device__ __forceinline__ void glds16(const void* gsrc, unsigned lds_dst) { unsigned keep;
    asm volatile("s_mov_b32 %0, m0\n\ts_mov_b32 m0, %2\n\ts_nop 0\n\tglobal_load_lds_dwordx4 %1, off\n\ts_mov_b32 m0, %0" : "=&s"(keep) : "v"(gsrc), "s"(lds_dst) : "memory"); }
#define WAIT_BAR0() asm volatile("s_waitcnt vmcnt(0) lgkmcnt(0)\n\ts_barrier" ::: "memory")
__device__ __forceinline__ void qkt(f32x16& p0, f32x16& p1, const LAS char* Kslot, const bf16x8* qr, int r32, int hi) {
    const LAS char* kb = Kslot + hi * 1024 + r32 * 16;
    const f32x16 z = {};
#pragma unroll
    for (int d0 = 0; d0 < 4; ++d0) {
        const bf16x8 b0 = *(const LAS bf16x8*)(kb + d0 * 2048);
        const bf16x8 b1 = *(const LAS bf16x8*)(kb + d0 * 2048 + 512);
        if (d0 == 0) { p0 = __builtin_amdgcn_mfma_f32_32x32x16_bf16(b0, qr[0], z, 0, 0, 0); p1 = __builtin_amdgcn_mfma_f32_32x32x16_bf16(b1, qr[0], z, 0, 0, 0); }
        else { p0 = __builtin_amdgcn_mfma_f32_32x32x16_bf16(b0, qr[d0], p0, 0, 0, 0); p1 = __builtin_amdgcn_mfma_f32_32x32x16_bf16(b1, qr[d0], p1, 0, 0, 0); } }
}
__device__ __forceinline__ float rowmax(const f32x16& p0, const f32x16& p1) {
    float a = fmaxf(fmaxf(p0[0], p0[1]), p1[0]), b = fmaxf(fmaxf(p0[2], p0[3]), p1[1]); a = fmaxf(fmaxf(a, p1[2]), p1[3]);
#pragma unroll
    for (int r = 4; r < 16; r += 4) { a = fmaxf(fmaxf(a, p0[r]), p0[r + 1]); b = fmaxf(fmaxf(b, p0[r + 2]), p0[r + 3]); a = fmaxf(fmaxf(a, p1[r]), p1[r + 1]); b = fmaxf(fmaxf(b, p1[r + 2]), p1[r + 3]); }
    const float m = fmaxf(a, b);
    auto rr = __builtin_amdgcn_permlane32_swap(__float_as_uint(m), __float_as_uint(m), false, false);
    return fmaxf(__uint_as_float(rr[0]), __uint_as_float(rr[1]));
}
__device__ __forceinline__ void pv(f32x16* o, int vb, bf16x8 pa0, bf16x8 pa1, bf16x8 pa2, bf16x8 pa3) {
#pragma unroll
    for (int d0 = 0; d0 < 2; ++d0) { s16x4 lo[4], hi[4];
#pragma unroll
        for (int ks = 0; ks < 4; ++ks) {
            asm volatile("ds_read_b64_tr_b16 %0,%1 offset:%c2" : "=&v"(lo[ks]) : "v"(vb), "i"(d0 * 4096 + ks * 1024) : "memory");
            asm volatile("ds_read_b64_tr_b16 %0,%1 offset:%c2" : "=&v"(hi[ks]) : "v"(vb), "i"(d0 * 4096 + ks * 1024 + 512) : "memory"); }
        asm volatile("s_waitcnt lgkmcnt(0)" ::: "memory"); SBAR();
#define PKV(k) (bf16x8){lo[k][0], lo[k][1], lo[k][2], lo[k][3], hi[k][0], hi[k][1], hi[k][2], hi[k][3]}
        o[d0] = __builtin_amdgcn_mfma_f32_32x32x16_bf16(pa0, PKV(0), o[d0], 0, 0, 0);
        o[d0] = __builtin_amdgcn_mfma_f32_32x32x16_bf16(pa1, PKV(1), o[d0], 0, 0, 0);
        o[d0] = __builtin_amdgcn_mfma_f32_32x32x16_bf16(pa2, PKV(2), o[d0], 0, 0, 0);
        o[d0] = __builtin_amdgcn_mfma_f32_32x32x16_bf16(pa3, PKV(3), o[d0], 0, 0, 0);
#undef PKV
    }
}
template <int MODE>
__device__ __forceinline__ void attn_unit(int b, int h, int qb, int jlo, const bf16_t* Z, bf16_t* CAT, const float* F2bh, LAS char* shm) {
    const int tid = threadIdx.x, lane = tid & 63, r32 = lane & 31, hi = lane >> 5; const int wid = __builtin_amdgcn_readfirstlane(tid >> 6);
    const long rowbase = (long)b * SEQ; const int q0 = qb * 256;
    const bf16_t* Qw = Z + (rowbase + q0 + wid * 32) * ZP + 512 + h * 64;
    const bf16_t* Kh = Z + rowbase * ZP + 1024 + h * 64; const bf16_t* Vh = Z + rowbase * ZP + 1536 + h * 64;
    const unsigned lds0 = (unsigned)(uintptr_t)shm;
    LAS float* wsf = (LAS float*)(shm + L_WS) + wid * 64;
    const bf16_t* ksrc = Kh + (long)lane * ZP + wid * 8;
    const bf16_t* vsrc = Vh + (long)(16 * (wid & 3) + (lane >> 2)) * ZP + (wid >> 2) * 32 + (lane & 3) * 8;
    const unsigned kdst = lds0 + L_K + wid * 1024, vdst = lds0 + L_V + wid * 1024;
#define DMA_K(t, slot) glds16(ksrc + (long)(t) * 64 * ZP, (unsigned)__builtin_amdgcn_readfirstlane(kdst + (slot)))
#define DMA_V(t, slot) glds16(vsrc + (long)(t) * 64 * ZP, (unsigned)__builtin_amdgcn_readfirstlane(vdst + (slot)))
    const int vb0 = (int)(lds0 + L_V) + ((lane >> 4) & 1) * 32 + (lane & 3) * 8 + (4 * hi + ((lane & 15) >> 2)) * 64;
    const int jhi = 4 * qb + 3;
    int mylo, myhi;
    if (MODE == 0) { const int cw = 4 * qb + (wid >> 1); mylo = cw - 8 < 0 ? 0 : cw - 8; myhi = cw; }
    else { mylo = jlo; myhi = 4 * qb + (wid >> 1); }
    DMA_K(jlo, 0); DMA_V(jlo, 0);
    float fq = 0.f;
    if (MODE == 1) {
        LAS float* fk = (LAS float*)(shm + L_FK); const int cnt = q0 + 256 - 64 * jlo;
        for (int i = tid; i < cnt; i += 512) fk[i] = F2bh[64 * jlo + i];
        fq = F2bh[q0 + wid * 32 + r32];
    }
    bf16x8 qr[4];
#pragma unroll
    for (int d0 = 0; d0 < 4; ++d0) qr[d0] = *(const bf16x8*)(Qw + (long)r32 * ZP + d0 * 16 + hi * 8);
    float m = -1e30f, l = 0.f; f32x16 o[2]; o[0] = f32x16{}; o[1] = f32x16{};
    const int qs = q0 + wid * 32 + r32;
    int slot = 0;
    for (int j = jlo; j <= jhi; ++j) {
        WAIT_BAR0();
        if (j < jhi) { DMA_K(j + 1, slot ^ SLOTB); DMA_V(j + 1, slot ^ SLOTB); }
        if (j >= mylo && j <= myhi) {
            f32x16 p0, p1;
            qkt(p0, p1, shm + L_K + slot, qr, r32, hi);
            if (MODE == 1) {
                const LAS float* fkl = (const LAS float*)(shm + L_FK) + (j - jlo) * 64 + 4 * hi;
#pragma unroll
                for (int r4 = 0; r4 < 4; ++r4) { const f32x4 a = *(const LAS f32x4*)(fkl + 8 * r4), c = *(const LAS f32x4*)(fkl + 32 + 8 * r4);
#pragma unroll
                    for (int i = 0; i < 4; ++i) { p0[4 * r4 + i] += fq - a[i]; p1[4 * r4 + i] += fq - c[i]; } }
                if (j == myhi) {
                    const int kb = 64 * j + 4 * hi;
#pragma unroll
                    for (int r = 0; r < 16; ++r) { const int kv = kb + (r & 3) + 8 * (r >> 2); if (kv > qs) p0[r] = -INFINITY; if (kv + 32 > qs) p1[r] = -INFINITY; }
                }
            } else {
                const LAS float* tab = (const LAS float*)(shm + L_TAB);
                const int dmin = (q0 + wid * 32) - (64 * j + 63);
                if (dmin >= 128) { const float c = tab[256];
#pragma unroll
                    for (int r = 0; r < 16; ++r) { p0[r] += c; p1[r] += c; } }
                else { const int base = qs - 64 * j - 4 * hi + 128;
#pragma unroll
                    for (int r = 0; r < 16; ++r) { int i0 = base - ((r & 3) + 8 * (r >> 2)); int i1 = i0 - 32;
                        i0 = i0 < 0 ? 0 : (i0 > 256 ? 256 : i0); i1 = i1 < 0 ? 0 : (i1 > 256 ? 256 : i1);
                        p0[r] += tab[i0]; p1[r] += tab[i1]; } }
            }
            const float rm = rowmax(p0, p1);
            const float mn = fmaxf(m, rm); const float alpha = __builtin_amdgcn_exp2f(m - mn); m = mn;
            float s0 = 0.f, s1 = 0.f;
#pragma unroll
            for (int r = 0; r < 16; ++r) { p0[r] = __builtin_amdgcn_exp2f(p0[r] - mn); p1[r] = __builtin_amdgcn_exp2f(p1[r] - mn); s0 += p0[r]; s1 += p1[r]; }
            l = l * alpha + (s0 + s1);
            if (hi == 0) wsf[r32] = alpha;
            LDS_WAIT();
#pragma unroll
            for (int r4 = 0; r4 < 4; ++r4) { const f32x4 a = *(const LAS f32x4*)(wsf + 8 * r4 + 4 * hi);
#pragma unroll
                for (int i = 0; i < 4; ++i) { o[0][4 * r4 + i] *= a[i]; o[1][4 * r4 + i] *= a[i]; } }
            u32x4 pw0, pw1, pw2, pw3;
            pw0 = (u32x4){pk2(p0[0], p0[1]), pk2(p0[2], p0[3]), pk2(p0[4], p0[5]), pk2(p0[6], p0[7])};
            pw1 = (u32x4){pk2(p0[8], p0[9]), pk2(p0[10], p0[11]), pk2(p0[12], p0[13]), pk2(p0[14], p0[15])};
            pw2 = (u32x4){pk2(p1[0], p1[1]), pk2(p1[2], p1[3]), pk2(p1[4], p1[5]), pk2(p1[6], p1[7])};
            pw3 = (u32x4){pk2(p1[8], p1[9]), pk2(p1[10], p1[11]), pk2(p1[12], p1[13]), pk2(p1[14], p1[15])};
            SBAR();
            pv(o, vb0 + slot, __builtin_bit_cast(bf16x8, pw0), __builtin_bit_cast(bf16x8, pw1), __builtin_bit_cast(bf16x8, pw2), __builtin_bit_cast(bf16x8, pw3));
        }
        slot ^= SLOTB;
    }
    { auto rr = __builtin_amdgcn_permlane32_swap(__float_as_uint(l), __float_as_uint(l), false, false); l = __uint_as_float(rr[0]) + __uint_as_float(rr[1]); }
    if (hi == 0) wsf[32 + r32] = l;
    LDS_WAIT();
    float rli[16];
#pragma unroll
    for (int r = 0; r < 16; ++r) rli[r] = __builtin_amdgcn_rcpf(wsf[32 + crow(r, hi)]);
    bf16_t* Ow = CAT + (rowbase + q0 + wid * 32) * 1024 + 512 + h * 64;
    { LAS bf16_t* stg = (LAS bf16_t*)(shm + L_OST) + wid * 2048;
#pragma unroll
        for (int r = 0; r < 16; ++r) { const int orow = crow(r, hi);
#pragma unroll
            for (int d0 = 0; d0 < 2; ++d0) stg[orow * 64 + d0 * 32 + r32] = (bf16_t)(pk2(o[d0][r] * rli[r], 0.f) & 0xffffu); }
        LDS_WAIT();
#pragma unroll
        for (int i = 0; i < 4; ++i) { const int row = i * 8 + (lane >> 3), ch = lane & 7; const u32x4 v = *(const LAS u32x4*)(stg + row * 64 + ch * 8); *(u32x4*)(Ow + (long)row * 1024 + ch * 8) = v; } }
    asm volatile("s_waitcnt lgkmcnt(0)\n\ts_barrier" ::: "memory");
#undef DMA_K
#undef DMA_V
}
#undef SBAR
#undef WAIT_BAR0
}
namespace thin {
using att::crow;
__device__ __forceinline__ void ada_mod(const float* c, const float* mod_w, const float* mod_b, float* modv, LAS unsigned char* lds, int tid, int lane, int wid) {
    LAS float* sc = (LAS float*)lds;
    LAS float* part = sc + 2048;
    for (int i = tid; i < 2048; i += 512) { const float v = c[i]; sc[i] = v / (1.f + __expf(-v)); }
    __syncthreads();
    for (int item = blockIdx.x; item < 192; item += gridDim.x) {
        const int lj = item / 48, cg = item % 48, n = cg * 64 + lane;
        const float* w = mod_w + (size_t)lj * 1024 * 3072 + n;
        float a0 = 0.f, a1 = 0.f;
#pragma unroll 16
        for (int kk = 0; kk < 128; ++kk) { const int k = wid * 128 + kk; const float wv = w[(size_t)k * 3072]; a0 += sc[k] * wv; a1 += sc[1024 + k] * wv; }
        part[(wid * 2 + 0) * 64 + lane] = a0; part[(wid * 2 + 1) * 64 + lane] = a1;
        __syncthreads();
        if (wid < 2) { float s = 0.f;
#pragma unroll
            for (int w8 = 0; w8 < 8; ++w8) s += part[(w8 * 2 + wid) * 64 + lane];
            modv[(lj * 2 + wid) * 3072 + n] = s + mod_b[lj * 3072 + n]; }
        __syncthreads();
    }
}
__device__ __forceinline__ void tr_item(const float* W, int ldw, int k0, int n0, bf16_t* WT, int ldt, size_t drow, int dk, LAS float* scr, int lane) {
    float v[32];
#pragma unroll
    for (int i = 0; i < 32; ++i) { const int kk = 2 * i + (lane >> 5); v[i] = W[(size_t)(k0 + kk) * ldw + n0 + (lane & 31)]; }
#pragma unroll
    for (int i = 0; i < 32; ++i) scr[(2 * i + (lane >> 5)) * 33 + (lane & 31)] = v[i];
    LDS_WAIT(); asm volatile("" ::: "memory");
    const int c = lane & 7;
#pragma unroll
    for (int j = 0; j < 4; ++j) { const int n = (lane >> 3) + 8 * j; const LAS float* s = scr + (8 * c) * 33 + n;
        u32x4 o; o.x = pk2(s[0 * 33], s[1 * 33]); o.y = pk2(s[2 * 33], s[3 * 33]); o.z = pk2(s[4 * 33], s[5 * 33]); o.w = pk2(s[6 * 33], s[7 * 33]);
        *(u32x4*)(WT + (drow + n) * (size_t)ldt + dk + k0 + 8 * c) = o; }
    LDS_WAIT(); asm volatile("" ::: "memory");
}
__device__ __forceinline__ void tr_matrix_item(const float* W, int ldw, int N, int it, bf16_t* WT, int ldt, int dk, LAS float* scr, int lane) {
    const int nblk = N / 32, kb = it / nblk, nb = it % nblk;
    tr_item(W, ldw, 64 * kb, 32 * nb, WT, ldt, (size_t)(32 * nb), dk, scr, lane);
}
__device__ __forceinline__ void tr_gu_item(const float* W, int it, bf16_t* WT, LAS float* scr, int lane) {
    const int kb = it / 64, nb = it % 64, n0 = 32 * nb;
    const int n2 = n0 & 1023; const size_t drow = (size_t)((n2 >> 7) * 256 + (n0 >= 1024 ? 128 : 0) + (n2 & 127));
    tr_item(W, 2048, 64 * kb, n0, WT, 1024, drow - 0, 0, scr, lane);
}
__device__ __forceinline__ void fold_item(const float* pool_w, const float* pool_scale, const float* w_out, int it, bf16_t* WT, int lane) {
    const int kb = it >> 4, nb = it & 15, n = nb * 64 + lane, k0 = kb * 8, g = k0 >> 7;
    float acc[8] = {0.f, 0.f, 0.f, 0.f, 0.f, 0.f, 0.f, 0.f};
    const float* pw = pool_w + (size_t)g * 128 * 128 + (size_t)(k0 & 127) * 128;
#pragma unroll 4
    for (int d = 0; d < 128; ++d) { const float wv = w_out[(size_t)(g * 128 + d) * 1024 + n] * pool_scale[g * 128 + d];
#pragma unroll
        for (int kk = 0; kk < 8; ++kk) acc[kk] += pw[kk * 128 + d] * wv; }
    u32x4 o; o.x = pk2(acc[0], acc[1]); o.y = pk2(acc[2], acc[3]); o.z = pk2(acc[4], acc[5]); o.w = pk2(acc[6], acc[7]);
    *(u32x4*)(WT + (size_t)n * 1024 + k0) = o;
}
__device__ __forceinline__ void mod_row(const float* xrow, const float* mv, bf16_t* orow, int lane) {
#pragma unroll
    for (int j = 0; j < 4; ++j) { const int col = 4 * lane + 256 * j;
        const f32x4 x = *(const f32x4*)(xrow + col), sh = *(const f32x4*)(mv + col), sc = *(const f32x4*)(mv + 1024 + col);
        const f32x4 h = x * (1.f + sc) + sh; u32x2 w; w.x = pk2(h[0], h[1]); w.y = pk2(h[2], h[3]); *(u32x2*)(orow + col) = w; }
}
__device__ __forceinline__ void pool_row(const bf16_t* Z, int t, bf16_t* CAT, int lane) {
    const int s = t & (SEQ - 1), g = lane >> 4, win = 2 << g;
    float acc[8] = {0.f, 0.f, 0.f, 0.f, 0.f, 0.f, 0.f, 0.f}, own[8];
#pragma unroll
    for (int i = 0; i < 16; ++i) {
        if (i < win && s - i >= 0) { const u32x4 w = *(const u32x4*)(Z + (size_t)(t - i) * ZP + 8 * lane);
            const float f[8] = {bflo(w.x), bfhi(w.x), bflo(w.y), bfhi(w.y), bflo(w.z), bfhi(w.z), bflo(w.w), bfhi(w.w)};
#pragma unroll
            for (int q = 0; q < 8; ++q) { acc[q] += f[q]; if (i == 0) own[q] = f[q]; } } }
    const int cnt = (s + 1 < win) ? s + 1 : win; const float inv = 1.f / (float)cnt;
    u32x4 o; o.x = pk2(acc[0] * inv - own[0], acc[1] * inv - own[1]); o.y = pk2(acc[2] * inv - own[2], acc[3] * inv - own[3]);
    o.z = pk2(acc[4] * inv - own[4], acc[5] * inv - own[5]); o.w = pk2(acc[6] * inv - own[6], acc[7] * inv - own[7]);
    *(u32x4*)(CAT + (size_t)t * 1024 + 8 * lane) = o;
}
struct LnrArgs { const float* xres; const float* Y; const float* mvA; const float* mvB; const float* lg; const float* lb; float* X1; bf16_t* H2; const bf16_t* WrT; const float* rb;
                 unsigned* count; int* top_e; float* gates; int* pos; };
__device__ __forceinline__ void lnr_phase(const LnrArgs& a, LAS unsigned char* lds, int tid, int lane, int wid) {
    constexpr int AP = 2064;
    LAS unsigned char* At = lds; LAS float* red = (LAS float*)(lds + 32 * AP); LAS float* lg2 = red + 8 * 32 * 33;
    const int r32 = lane & 31, hi = lane >> 5;
    for (int tile = blockIdx.x; tile < T_TOK / 32; tile += gridDim.x) {
#pragma unroll 1
        for (int q = 0; q < 4; ++q) { const int tl = wid * 4 + q, t = tile * 32 + tl, b = t / SEQ;
            const float* xr = a.xres + (size_t)t * DM; const float* yr = a.Y + (size_t)t * DM; const float* gA = a.mvA + b * 3072 + 2048; const float* mB = a.mvB + b * 3072;
            f32x4 v[4]; float s = 0.f;
#pragma unroll
            for (int j = 0; j < 4; ++j) { const int col = 4 * lane + 256 * j; const f32x4 x = *(const f32x4*)(xr + col), y = *(const f32x4*)(yr + col), g = *(const f32x4*)(gA + col);
                v[j] = DN_ALPHA * x + (1.f + g) * y; s += (v[j][0] + v[j][1]) + (v[j][2] + v[j][3]); }
            const float mean = wave_sum(s) * (1.f / DM); float s2 = 0.f;
#pragma unroll
            for (int j = 0; j < 4; ++j) { v[j] = v[j] - mean; s2 += (v[j][0] * v[j][0] + v[j][1] * v[j][1]) + (v[j][2] * v[j][2] + v[j][3] * v[j][3]); }
            const float rstd = 1.f / sqrtf(wave_sum(s2) * (1.f / DM) + LN_EPS);
#pragma unroll
            for (int j = 0; j < 4; ++j) { const int col = 4 * lane + 256 * j; const f32x4 g = *(const f32x4*)(a.lg + col), bb = *(const f32x4*)(a.lb + col);
                const f32x4 x1 = v[j] * rstd * g + bb; *(f32x4*)(a.X1 + (size_t)t * DM + col) = x1;
                const f32x4 sh = *(const f32x4*)(mB + col), sc = *(const f32x4*)(mB + 1024 + col); const f32x4 h = x1 * (1.f + sc) + sh;
                u32x2 w; w.x = pk2(h[0], h[1]); w.y = pk2(h[2], h[3]);
                *(u32x2*)(a.H2 + (size_t)t * DM + col) = w; *(LAS u32x2*)(At + tl * AP + col * 2) = w; }
        }
        __syncthreads();
        { f32x16 acc = {};
#pragma unroll
            for (int s = 0; s < 8; ++s) { const int kb = 128 * wid + 16 * s + 8 * hi;
                const bf16x8 af = *(const LAS bf16x8*)(At + r32 * AP + kb * 2); const bf16x8 bfr = *(const bf16x8*)(a.WrT + (size_t)r32 * 1024 + kb);
                acc = __builtin_amdgcn_mfma_f32_32x32x16_bf16(af, bfr, acc, 0, 0, 0); }
#pragma unroll
            for (int r = 0; r < 16; ++r) red[(wid * 32 + crow(r, hi)) * 33 + r32] = acc[r]; }
        __syncthreads();
        { const int tok = tid >> 4;
#pragma unroll
            for (int q = 0; q < 2; ++q) { const int e = (tid & 15) * 2 + q; float s = a.rb[e];
#pragma unroll
                for (int w = 0; w < 8; ++w) s += red[(w * 32 + tok) * 33 + e];
                lg2[tok * 33 + e] = s; } }
        __syncthreads();
        if (wid == 0) {
            const bool act = lane < 32; const int tok = lane & 31, t = tile * 32 + tok;
            float v[32];
#pragma unroll
            for (int i = 0; i < 32; ++i) v[i] = lg2[tok * 33 + i];
            int e[4]; float tv[4]; unsigned taken = 0u;
#pragma unroll
            for (int k = 0; k < 4; ++k) { int bi = 0; float bv = -INFINITY;
#pragma unroll
                for (int i = 0; i < 32; ++i) { const bool ok = !((taken >> i) & 1u) && (v[i] > bv); bv = ok ? v[i] : bv; bi = ok ? i : bi; }
                e[k] = bi; tv[k] = bv; taken |= 1u << bi; }
            float ex[4], sum = 0.f;
#pragma unroll
            for (int k = 0; k < 4; ++k) { ex[k] = __expf(tv[k] - tv[0]); sum += ex[k]; }
            const float inv = 1.f / sum;
            int cnt = 0; int rank[4];
#pragma unroll
            for (int k = 0; k < 4; ++k) { const int ek = act ? e[k] : -1; const int prev = __shfl(cnt, e[k]); int myrank = 0;
#pragma unroll 1
                for (int ee = 0; ee < 32; ++ee) { const unsigned long long mk = __ballot(ek == ee); if (ek == ee) myrank = __popcll(mk & ((1ull << lane) - 1ull)); if (lane == ee) cnt += __popcll(mk); }
                rank[k] = prev + myrank; }
            int base = 0; if (act && cnt > 0) base = (int)atomicAdd(a.count + lane, (unsigned)cnt);
#pragma unroll
            for (int k = 0; k < 4; ++k) { const int p = __shfl(base, e[k]) + rank[k];
                if (act) { a.top_e[t * 4 + k] = e[k]; a.gates[t * 4 + k] = ex[k] * inv; a.pos[t * 4 + k] = p; } }
        }
        __syncthreads();
    }
}
__device__ __forceinline__ void fill_phase(const unsigned* count, const int* top_e, const int* pos, int* pstart_g, int* tile_e, int* slot_of_pair, const bf16_t* H2, bf16_t* XG,
                                           LAS unsigned char* lds, int tid, int lane, int gw, int ngw) {
    LAS int* ps = (LAS int*)lds;
    if (tid == 0) { int acc = 0; for (int e = 0; e < 32; ++e) { ps[e] = acc; acc += ((int)count[e] + 255) / 256 * 256; } ps[32] = acc; }
    __syncthreads();
    if (blockIdx.x == 0) { if (tid < 33) pstart_g[tid] = ps[tid];
        for (int rt = tid; rt < MAXTILES; rt += 512) { const int row = rt * 256; int e = 0; for (int i = 1; i < 32; ++i) if (row >= ps[i]) e = i; tile_e[rt] = e; } }
    for (int t = gw; t < T_TOK; t += ngw) {
        int slot = 0; if (lane < 4) { slot = ps[top_e[t * 4 + lane]] + pos[t * 4 + lane]; slot_of_pair[t * 4 + lane] = slot; }
        const u32x4 v0 = *(const u32x4*)(H2 + (size_t)t * DM + lane * 8), v1 = *(const u32x4*)(H2 + (size_t)t * DM + 512 + lane * 8);
#pragma unroll
        for (int k = 0; k < 4; ++k) { const int sk = __shfl(slot, k); bf16_t* d = XG + (size_t)sk * DM; *(u32x4*)(d + lane * 8) = v0; *(u32x4*)(d + 512 + lane * 8) = v1; }
    }
}
struct CombArgs { const bf16_t* YP; const int* slot_of_pair; const float* gates; const float* X1; const float* mvB; const float* lg; const float* lb; float* OUT;
                  const float* mvN; bf16_t* HB; const float* Wf; const float* fb; float* FL; };
__device__ __forceinline__ void combine_row(const CombArgs& a, int t, int lane) {
    const int b = t / SEQ;
    int sl[4]; float gk[4];
#pragma unroll
    for (int k = 0; k < 4; ++k) { sl[k] = a.slot_of_pair[t * 4 + k]; gk[k] = a.gates[t * 4 + k]; }
    const float* xr = a.X1 + (size_t)t * DM; const float* gB = a.mvB + b * 3072 + 2048;
    f32x4 v[4]; float s = 0.f;
#pragma unroll
    for (int j = 0; j < 4; ++j) { const int col = 4 * lane + 256 * j; f32x4 y = {0.f, 0.f, 0.f, 0.f};
#pragma unroll
        for (int k = 0; k < 4; ++k) { const u32x2 w = *(const u32x2*)(a.YP + (size_t)sl[k] * DM + col); y[0] += gk[k] * bflo(w.x); y[1] += gk[k] * bfhi(w.x); y[2] += gk[k] * bflo(w.y); y[3] += gk[k] * bfhi(w.y); }
        const f32x4 x = *(const f32x4*)(xr + col), g = *(const f32x4*)(gB + col);
        v[j] = DN_ALPHA * x + (1.f + g) * y; s += (v[j][0] + v[j][1]) + (v[j][2] + v[j][3]); }
    const float mean = wave_sum(s) * (1.f / DM); float s2 = 0.f;
#pragma unroll
    for (int j = 0; j < 4; ++j) { v[j] = v[j] - mean; s2 += (v[j][0] * v[j][0] + v[j][1] * v[j][1]) + (v[j][2] * v[j][2] + v[j][3] * v[j][3]); }
    const float rstd = 1.f / sqrtf(wave_sum(s2) * (1.f / DM) + LN_EPS);
    float fl[8] = {0.f, 0.f, 0.f, 0.f, 0.f, 0.f, 0.f, 0.f};
#pragma unroll
    for (int j = 0; j < 4; ++j) { const int col = 4 * lane + 256 * j; const f32x4 g = *(const f32x4*)(a.lg + col), bb = *(const f32x4*)(a.lb + col);
        const f32x4 x2 = v[j] * rstd * g + bb; *(f32x4*)(a.OUT + (size_t)t * DM + col) = x2;
        if (a.mvN) { const float* mN = a.mvN + b * 3072; const f32x4 sh = *(const f32x4*)(mN + col), sc = *(const f32x4*)(mN + 1024 + col); const f32x4 h = x2 * (1.f + sc) + sh;
            u32x2 w; w.x = pk2(h[0], h[1]); w.y = pk2(h[2], h[3]); *(u32x2*)(a.HB + (size_t)t * DM + col) = w;
#pragma unroll
            for (int hh = 0; hh < 8; ++hh) { const f32x4 wf = *(const f32x4*)(a.Wf + hh * 1024 + col); fl[hh] += (h[0] * wf[0] + h[1] * wf[1]) + (h[2] * wf[2] + h[3] * wf[3]); } } }
    if (a.mvN) {
        float mine = 0.f;
#pragma unroll
        for (int hh = 0; hh < 8; ++hh) { const float tot = wave_sum(fl[hh]); if (lane == hh) mine = tot; }
        if (lane < 8) { const float x = mine + a.fb[lane]; a.FL[t * 8 + lane] = fminf(x, 0.f) - log1pf(__expf(-fabsf(x))); }
    }
}
struct S5Par { float ar, ai, bbr[16], bbi[16]; };
__device__ __forceinline__ void s5_params(S5Par& P, int g, int p, const float* lam_re, const float* lam_im, const float* log_dt, const float* b_re, const float* b_im) {
    const float dt = expf(log_dt[g]); const float lre = fminf(lam_re[g * 64 + p], -1e-4f), lim = lam_im[g * 64 + p];
    const float mag = expf(lre * dt); P.ar = mag * cosf(lim * dt); P.ai = mag * sinf(lim * dt);
    const float den = lre * lre + lim * lim, nre = P.ar - 1.f, nim = P.ai;
    const float gre = (nre * lre + nim * lim) / den, gim = (nim * lre - nre * lim) / den;
#pragma unroll
    for (int c = 0; c < 16; ++c) { const float br = b_re[(g * 64 + p) * 16 + c], bi = b_im[(g * 64 + p) * 16 + c]; P.bbr[c] = gre * br - gim * bi; P.bbi[c] = gre * bi + gim * br; }
}
__device__ __forceinline__ void s5_load_u(const bf16_t* Z, size_t t, int g, float (&u)[16]) {
    const u32x4* up = (const u32x4*)(Z + t * ZP + g * 16); const u32x4 w0 = up[0], w1 = up[1];
    u[0] = bflo(w0.x); u[1] = bfhi(w0.x); u[2] = bflo(w0.y); u[3] = bfhi(w0.y); u[4] = bflo(w0.z); u[5] = bfhi(w0.z); u[6] = bflo(w0.w); u[7] = bfhi(w0.w);
    u[8] = bflo(w1.x); u[9] = bfhi(w1.x); u[10] = bflo(w1.y); u[11] = bfhi(w1.y); u[12] = bflo(w1.z); u[13] = bfhi(w1.z); u[14] = bflo(w1.w); u[15] = bfhi(w1.w);
}
__device__ __forceinline__ void s5_pass1(const bf16_t* Z, float* SLOC, int gw, int lane, const float* lam_re, const float* lam_im, const float* log_dt, const float* b_re, const float* b_im) {
    const int it0 = gw * 4, bg = it0 >> 7, c0 = it0 & 127, b = bg >> 5, g = bg & 31;
    S5Par P; s5_params(P, g, lane, lam_re, lam_im, log_dt, b_re, b_im);
#pragma unroll 1
    for (int q = 0; q < 4; ++q) { const int c = c0 + q; float xr = 0.f, xi = 0.f;
#pragma unroll 4
        for (int j = 0; j < 64; ++j) { float u[16]; s5_load_u(Z, (size_t)b * SEQ + c * 64 + j, g, u); float bur = 0.f, bui = 0.f;
#pragma unroll
            for (int cc = 0; cc < 16; ++cc) { bur += P.bbr[cc] * u[cc]; bui += P.bbi[cc] * u[cc]; }
            const float nxr = P.ar * xr - P.ai * xi + bur, nxi = P.ar * xi + P.ai * xr + bui; xr = nxr; xi = nxi; }
        *(f32x2*)(SLOC + ((size_t)(bg * 128 + c) * 64 + lane) * 2) = (f32x2){xr, xi}; }
}
__device__ __forceinline__ void s5_pass3(const bf16_t* Z, const float* SLOC, bf16_t* YG, int gw, int lane, LAS unsigned char* wlds  ,
                                         const float* lam_re, const float* lam_im, const float* log_dt, const float* b_re, const float* b_im, const float* c_re, const float* c_im, const float* d_skip) {
    const int it0 = gw * 4, bg = it0 >> 7, c0 = it0 & 127, b = bg >> 5, g = bg & 31;
    S5Par P; s5_params(P, g, lane, lam_re, lam_im, log_dt, b_re, b_im);
    float a64r = P.ar, a64i = P.ai;
#pragma unroll
    for (int i = 0; i < 6; ++i) { const float nr = a64r * a64r - a64i * a64i, ni = 2.f * a64r * a64i; a64r = nr; a64i = ni; }
    const int cc = lane & 15, part = lane >> 4;
    float cre[16], cim[16];
#pragma unroll
    for (int i = 0; i < 16; ++i) { cre[i] = c_re[(g * 16 + cc) * 64 + 16 * part + i]; cim[i] = c_im[(g * 16 + cc) * 64 + 16 * part + i]; }
    const float dsk = d_skip[g * 16 + cc];
    float xr = 0.f, xi = 0.f;
    { float pr = 1.f, pi = 0.f;
#pragma unroll 4
        for (int cp = c0 - 1; cp >= 0; --cp) { const f32x2 s = *(const f32x2*)(SLOC + ((size_t)(bg * 128 + cp) * 64 + lane) * 2);
            xr += pr * s.x - pi * s.y; xi += pr * s.y + pi * s.x; const float nr = pr * a64r - pi * a64i, ni = pr * a64i + pi * a64r; pr = nr; pi = ni; } }
    LAS float* XS = (LAS float*)wlds; LAS bf16_t* YO = (LAS bf16_t*)(wlds + 512);
#pragma unroll 1
    for (int q = 0; q < 4; ++q) { const int c = c0 + q;
#pragma unroll 2
        for (int j = 0; j < 64; ++j) { const size_t t = (size_t)b * SEQ + c * 64 + j; float u[16]; s5_load_u(Z, t, g, u); float bur = 0.f, bui = 0.f;
#pragma unroll
            for (int k = 0; k < 16; ++k) { bur += P.bbr[k] * u[k]; bui += P.bbi[k] * u[k]; }
            const float nxr = P.ar * xr - P.ai * xi + bur, nxi = P.ar * xi + P.ai * xr + bui; xr = nxr; xi = nxi;
            XS[lane] = xr; XS[64 + lane] = xi;
            float y = 0.f;
#pragma unroll
            for (int i4 = 0; i4 < 4; ++i4) { const f32x4 a = *(const LAS f32x4*)(XS + 16 * part + 4 * i4), bq = *(const LAS f32x4*)(XS + 64 + 16 * part + 4 * i4);
#pragma unroll
                for (int i = 0; i < 4; ++i) y += cre[4 * i4 + i] * a[i] - cim[4 * i4 + i] * bq[i]; }
            y += __shfl_xor(y, 16); y += __shfl_xor(y, 32);
            const float uc = bf2f(Z[t * ZP + g * 16 + cc]);
            y += dsk * uc;
            const float z2 = 1.5957691216057308f * (y + 0.044715f * y * y * y);
            const float ge = y * fast_sigmoid(z2);
            if (lane < 16) YO[j * 16 + lane] = (bf16_t)(pk2(ge, 0.f) & 0xffffu);
        }
        LDS_WAIT();
#pragma unroll
        for (int ps = 0; ps < 2; ++ps) { const int tok = (lane >> 1) + 32 * ps, half = lane & 1; const u32x4 v = *(const LAS u32x4*)(YO + tok * 16 + half * 8);
            *(u32x4*)(YG + ((size_t)b * SEQ + c * 64 + tok) * 512 + g * 16 + half * 8) = v; }
        LDS_WAIT();
    }
}
__device__ __forceinline__ void f2_scan(const float* FL, float* F2, int bh, int lane) {
    const int b = bh >> 3, h = bh & 7; const float* src = FL + ((size_t)b * SEQ + 128 * lane) * 8 + h;
    float loc = 0.f;
#pragma unroll 16
    for (int i = 0; i < 128; ++i) loc += src[i * 8];
    float inc = loc;
#pragma unroll
    for (int o = 1; o < 64; o <<= 1) { const float n = __shfl_up(inc, o); if (lane >= o) inc += n; }
    float run = inc - loc; float* dst = F2 + (size_t)bh * SEQ + 128 * lane;
#pragma unroll 16
    for (int i = 0; i < 128; ++i) { run += src[i * 8]; dst[i] = run * LOG2E; }
}
}
typedef GAS unsigned gu32;
#define XB_TMO      128
#define XB_XCNT(j)  (256  + 64 * (j))
#define XB_XSUB(j)  (1280 + 64 * (j))
#define XB_XGEN(j)  (2304 + 64 * (j))
#define XB_TOP      3328
#define XB_TOPGEN   3392
#define XCD_BAR_WORDS 3456
#define XB_SPIN_CAP (1u << 18)

__device__ __forceinline__ unsigned xb_ld(unsigned* p)              { return __hip_atomic_load(p, __ATOMIC_RELAXED, __HIP_MEMORY_SCOPE_AGENT); }
__device__ __forceinline__ unsigned xb_add(unsigned* p, unsigned v) { return __hip_atomic_fetch_add(p, v, __ATOMIC_RELAXED, __HIP_MEMORY_SCOPE_AGENT); }
__device__ __forceinline__ unsigned xb_xcc_id() { return (unsigned)__builtin_amdgcn_s_getreg((3 << 11) | 20) & 0xFu; }
#define XB_SPIN(cond, bar) do { unsigned _sp = 0; while (cond) { __builtin_amdgcn_s_sleep(1); \
    if ((++_sp & 255u) == 0u) { if (xb_ld(&(bar)[XB_TMO])) break; if (_sp > XB_SPIN_CAP) { atomicAdd(&(bar)[XB_TMO], 1u); break; } } } } while (0)

struct XcdBarrier {
    unsigned* bar; unsigned x;
    volatile LAS unsigned* st;
};

__device__ __forceinline__ XcdBarrier xcd_barrier_post(unsigned* bar, volatile LAS unsigned* st) {
    XcdBarrier b; b.bar = bar; b.x = xb_xcc_id(); b.st = st;
    if (threadIdx.x == 0) (void)xb_add(&bar[XB_XCNT(b.x)], 1u);
    return b;
}
__device__ __forceinline__ void xcd_barrier_complete(unsigned* bar, unsigned x, unsigned& nloc, unsigned& nx) {
    const unsigned G = gridDim.x * gridDim.y * gridDim.z;
    unsigned sum, cnt, mine, sp = 0u;
    for (;;) {
        sum = 0u; cnt = 0u; mine = 0u;
#pragma unroll
        for (unsigned j = 0; j < 16; ++j) { const unsigned c = xb_ld(&bar[XB_XCNT(j)]); sum += c; cnt += (c > 0u) ? 1u : 0u; mine = (j == x) ? c : mine; }
        if (sum == G) break;
        __builtin_amdgcn_s_sleep(1);
        if ((++sp & 255u) == 0u) { if (xb_ld(&bar[XB_TMO])) break; if (sp > XB_SPIN_CAP) { atomicAdd(&bar[XB_TMO], 1u); break; } }
    }
    nloc = mine > 0u ? mine : 1u; nx = cnt > 0u ? cnt : 1u;
}

__device__ __forceinline__ void xcd_barrier(const XcdBarrier& b) {
    asm volatile("s_waitcnt vmcnt(0)" ::: "memory");
    __syncthreads();
    if (threadIdx.x == 0) {
        unsigned* bar = b.bar;
        __builtin_amdgcn_s_waitcnt(0);
        unsigned nloc = b.st[0], nx = b.st[1];
        if (nloc == 0u) { xcd_barrier_complete(bar, b.x, nloc, nx); b.st[0] = nloc; b.st[1] = nx; }
        const unsigned old = xb_add(&bar[XB_XSUB(b.x)], 1u);
        const unsigned gen = old / nloc;
        if (old + 1u == (gen + 1u) * nloc) {
            __builtin_amdgcn_fence(__ATOMIC_RELEASE, "agent");
            asm volatile("s_waitcnt vmcnt(0)" ::: "memory");
            const unsigned og = xb_add(&bar[XB_TOP], 1u);
            const unsigned tg = og / nx;
            if (og + 1u == (tg + 1u) * nx) xb_add(&bar[XB_TOPGEN], 1u);
            else XB_SPIN(xb_ld(&bar[XB_TOPGEN]) == tg, bar);
            __builtin_amdgcn_fence(__ATOMIC_ACQUIRE, "agent");
            xb_add(&bar[XB_XGEN(b.x)], 1u);
            asm volatile("s_waitcnt vmcnt(0)" ::: "memory");
        } else {
            XB_SPIN(xb_ld(&bar[XB_XGEN(b.x)]) == gen, bar);
            __builtin_amdgcn_fence(__ATOMIC_ACQUIRE, "agent");
            asm volatile("s_waitcnt vmcnt(0)" ::: "memory");
        }
    }
    __syncthreads();
}
namespace cg = cooperative_groups;
constexpr size_t MiB = 1u << 20;
constexpr size_t WS_CTL = 0, CTL_BYTES = 1 * MiB;
constexpr size_t WS_MODV = 1 * MiB, WS_WF = 1 * MiB + 512 * 1024, WS_WRT = 1 * MiB + 768 * 1024;
constexpr size_t WS_WIN0 = 2 * MiB, WS_WOUT0 = 6 * MiB, WS_WIN1 = 8 * MiB, WS_WOUT1 = 12 * MiB, WS_WGLU = 14 * MiB, WS_INTS = 15 * MiB;
constexpr size_t WS_WGU = 16 * MiB, WS_WDN = 272 * MiB, WS_HB = 400 * MiB, WS_Z = 432 * MiB, WS_CAT = 496 * MiB, WS_Y = 528 * MiB, WS_X1 = 592 * MiB, WS_X2 = 656 * MiB, WS_H2 = 720 * MiB;
constexpr size_t WS_XG = 752 * MiB, WS_ACT = 896 * MiB, WS_ROUTE = 1040 * MiB, WS_FL = 1042 * MiB, WS_F2 = 1042 * MiB + 512 * 1024, WS_SLOC = 1044 * MiB, WS_YG = 1048 * MiB, WS_END = 1064 * MiB;
constexpr int CW_BAR = 4096;
constexpr int MISC_OFF = 131072 + 512;
constexpr int CW_COUNT = 8192;
constexpr int LDS_BYTES = 147456;
constexpr int S5_LDS_OFF = 102400;
static_assert(att::L_END <= S5_LDS_OFF && S5_LDS_OFF + 8 * 2560 <= 131072, "LDS map");


struct Params { const float* in[30]; float* out; unsigned char* ws; };
#define KAS __attribute__((address_space(4)))
#define PH_BEGIN \
    const KAS Params* kp = (const KAS Params*)__builtin_amdgcn_kernarg_segment_ptr(); asm volatile("" : "+s"(kp)); \
    int tid = threadIdx.x; asm volatile("" : "+v"(tid)); const int lane = tid & 63; const int wid = __builtin_amdgcn_readfirstlane(tid >> 6); \
    int bx = blockIdx.x; asm volatile("" : "+s"(bx)); const int gw = bx * 8 + wid; constexpr int ngw = 2048, G = 256; (void)lane; (void)gw; (void)ngw; (void)G;
#define GSYNC_CG() cg::this_grid().sync()
#define GSYNC() do { PH_BEGIN XcdBarrier b_; b_.bar = (unsigned*)(ctl + CW_BAR); b_.x = xb_xcc_id(); b_.st = (volatile LAS unsigned*)(lds + MISC_OFF); xcd_barrier(b_); } while (0)
#define IN(i) (kp->in[i])
#define WSP(T, off) ((T*)(kp->ws + (off)))
#define x_in IN(0)
#define cvec IN(1)
#define mod_w IN(2)
#define mod_b IN(3)
#define ln_g IN(4)
#define ln_b IN(5)
#define even_w_in IN(6)
#define pool_w IN(7)
#define pool_scale IN(8)
#define rel_bias IN(9)
#define even_w_out IN(10)
#define odd_w_in IN(11)
#define forget_b IN(12)
#define lam_re IN(13)
#define lam_im IN(14)
#define log_dt IN(15)
#define b_re IN(16)
#define b_im IN(17)
#define c_re IN(18)
#define c_im IN(19)
#define d_skip IN(20)
#define glu_w IN(21)
#define glu_b IN(22)
#define odd_w_out IN(23)
#define router_w IN(24)
#define router_b IN(25)
#define exp_w_gu IN(26)
#define exp_b_gu IN(27)
#define exp_w_down IN(28)
#define exp_b_down IN(29)
#define ctl WSP(unsigned, WS_CTL)
#define MODV WSP(float, WS_MODV)
#define WF WSP(float, WS_WF)
#define WRT WSP(bf16_t, WS_WRT)
#define W_IN0 WSP(bf16_t, WS_WIN0)
#define W_OUT0 WSP(bf16_t, WS_WOUT0)
#define W_IN1 WSP(bf16_t, WS_WIN1)
#define W_OUT1 WSP(bf16_t, WS_WOUT1)
#define W_GLU WSP(bf16_t, WS_WGLU)
#define PSTART WSP(int, WS_INTS)
#define TILE_E (PSTART + 64)
#define W_GU WSP(bf16_t, WS_WGU)
#define W_DN WSP(bf16_t, WS_WDN)
#define HB WSP(bf16_t, WS_HB)
#define Z WSP(bf16_t, WS_Z)
#define CAT WSP(bf16_t, WS_CAT)
#define Y WSP(float, WS_Y)
#define X1 WSP(float, WS_X1)
#define X2 WSP(float, WS_X2)
#define H2 WSP(bf16_t, WS_H2)
#define XG WSP(bf16_t, WS_XG)
#define YP WSP(bf16_t, WS_XG)
#define ACT WSP(bf16_t, WS_ACT)
#define TOP_E WSP(int, WS_ROUTE)
#define GATES WSP(float, WS_ROUTE + 256 * 1024)
#define POS WSP(int, WS_ROUTE + 512 * 1024)
#define SLOT WSP(int, WS_ROUTE + 768 * 1024)
#define FL WSP(float, WS_FL)
#define F2 WSP(float, WS_F2)
#define SLOC WSP(float, WS_SLOC)
#define YG WSP(bf16_t, WS_YG)

template <int LAYER> __device__ __forceinline__ void layer_body(LAS unsigned char* lds) {
    { PH_BEGIN
      pg8::Gemm g{HB, LAYER ? W_IN1 : W_IN0, T_TOK, 2048, 1024}; pg8::StaticOrder S; S.init(T_TOK, 2048, G, bx); epi::EpiZ E{Z, ZP, 512, 1024, QSCALE};
      pg8::gemm_phase<epi::EpiZ, pg8::StaticOrder, true, true>(lds, g, S, E); }
    GSYNC();
    if (LAYER == 0) {
        { PH_BEGIN
          for (int t = gw; t < T_TOK; t += ngw) thin::pool_row(Z, t, CAT, lane); }
        { PH_BEGIN
          for (int ui = bx; ui < 512; ui += G) { const int bh = ui & 15, qb = ui >> 4, b = bh >> 3, h = bh & 7;
              if (tid < 257) ((LAS float*)(lds + att::L_TAB))[tid] = rel_bias[h * 257 + tid] * LOG2E;
              att::attn_unit<0>(b, h, qb, (4 * qb - 8 < 0) ? 0 : 4 * qb - 8, Z, CAT, nullptr, (LAS char*)lds); } }
    } else {
        { PH_BEGIN
          thin::s5_pass1(Z, SLOC, gw, lane, lam_re, lam_im, log_dt, b_re, b_im); }
        { PH_BEGIN
          if (gw < 16) thin::f2_scan(FL, F2, gw, lane); }
        GSYNC();
        { PH_BEGIN
          thin::s5_pass3(Z, SLOC, YG, gw, lane, lds + S5_LDS_OFF + wid * 2560, lam_re, lam_im, log_dt, b_re, b_im, c_re, c_im, d_skip); }
        { PH_BEGIN
          const int k = bx >> 4, bh = bx & 15, b = bh >> 3, h = bh & 7;
          att::attn_unit<1>(b, h, 31 - k, 0, Z, CAT, F2 + (size_t)bh * SEQ, (LAS char*)lds); }
        { PH_BEGIN
          const int k = bx >> 4, bh = bx & 15, b = bh >> 3, h = bh & 7;
          att::attn_unit<1>(b, h, k, 0, Z, CAT, F2 + (size_t)bh * SEQ, (LAS char*)lds); }
        GSYNC();
        { PH_BEGIN
          pg8::Gemm g{YG, W_GLU, T_TOK, 512, 512}; pg8::StaticOrder S; S.init(T_TOK, 512, G, bx); epi::EpiGlu E{CAT, YG, glu_b};
          pg8::gemm_phase<epi::EpiGlu, pg8::StaticOrder, true, true>(lds, g, S, E); }
    }
    GSYNC();
    { PH_BEGIN
      pg8::Gemm g{CAT, LAYER ? W_OUT1 : W_OUT0, T_TOK, 1024, 1024}; pg8::StaticOrder S; S.init(T_TOK, 1024, G, bx); epi::EpiF32 E{Y, 1024};
      pg8::gemm_phase<epi::EpiF32, pg8::StaticOrder, true, true>(lds, g, S, E); }
    GSYNC();
    { PH_BEGIN
      thin::LnrArgs a{LAYER ? X2 : x_in, Y, MODV + (LAYER * 2 + 0) * 2 * 3072, MODV + (LAYER * 2 + 1) * 2 * 3072, ln_g + (LAYER * 2 + 0) * 1024, ln_b + (LAYER * 2 + 0) * 1024, X1, H2,
                      WRT + LAYER * 32768, router_b + LAYER * 32, ctl + CW_COUNT + LAYER * 64, TOP_E, GATES, POS};
      thin::lnr_phase(a, lds, tid, lane, wid); }
    GSYNC();
    { PH_BEGIN
      thin::fill_phase(ctl + CW_COUNT + LAYER * 64, TOP_E, POS, PSTART, TILE_E, SLOT, H2, XG, lds, tid, lane, gw, ngw); }
    GSYNC();
    { PH_BEGIN
      const int R = PSTART[32] >> 8;
      pg8::Gemm g{XG, W_GU + (size_t)LAYER * 32 * 2097152, MAXROWS, 2048, 1024}; epi::MoeOrder S{R, 8, bx, TILE_E, (size_t)2097152 * 2}; epi::EpiSwiglu E{ACT, exp_b_gu + (size_t)LAYER * 32 * 2048};
      pg8::gemm_phase<epi::EpiSwiglu, epi::MoeOrder, true, true>(lds, g, S, E); }
    GSYNC();
    { PH_BEGIN
      const int R = PSTART[32] >> 8;
      pg8::Gemm g{ACT, W_DN + (size_t)LAYER * 32 * 1048576, MAXROWS, 1024, 1024}; epi::MoeOrder S{R, 4, bx, TILE_E, (size_t)1048576 * 2}; epi::EpiBiasBf16 E{YP, exp_b_down + (size_t)LAYER * 32 * 1024};
      pg8::gemm_phase<epi::EpiBiasBf16, epi::MoeOrder, true, true>(lds, g, S, E); }
    GSYNC();
    { PH_BEGIN
      thin::CombArgs a{YP, SLOT, GATES, X1, MODV + (LAYER * 2 + 1) * 2 * 3072, ln_g + (LAYER * 2 + 1) * 1024, ln_b + (LAYER * 2 + 1) * 1024, LAYER ? kp->out : X2,
                       LAYER ? nullptr : MODV + 2 * 2 * 3072, HB, WF, forget_b, FL};
      for (int t = gw; t < T_TOK; t += ngw) thin::combine_row(a, t, lane); }
}

__global__ void __launch_bounds__(512, 2) mega_fwd(Params p_unused) {
    extern __shared__ __attribute__((aligned(16))) unsigned char lds_raw[];
    LAS unsigned char* lds = (LAS unsigned char*)lds_raw;
    if (threadIdx.x < 16) ((LAS unsigned*)(lds + MISC_OFF))[threadIdx.x] = 0u;
    __syncthreads();
    { PH_BEGIN (void)xcd_barrier_post((unsigned*)(ctl + CW_BAR), (volatile LAS unsigned*)(lds + MISC_OFF)); }
    { PH_BEGIN
      thin::ada_mod(cvec, mod_w, mod_b, MODV, lds, tid, lane, wid); }
    __syncthreads();
    { PH_BEGIN
      LAS float* scr = (LAS float*)(lds + wid * 8448);
      for (int it = gw; it < 3968; it += ngw) { int r = it;
        if (r < 1024) { thin::tr_matrix_item(even_w_in, 2048, 2048, r, W_IN0, 1024, 0, scr, lane); continue; } r -= 1024;
        if (r < 256) { thin::tr_matrix_item(even_w_out + 512 * 1024, 1024, 1024, r, W_OUT0, 1024, 512, scr, lane); continue; } r -= 256;
        if (r < 1024) { thin::tr_matrix_item(odd_w_in, 2056, 2048, r, W_IN1, 1024, 0, scr, lane); continue; } r -= 1024;
        if (r < 512) { thin::tr_matrix_item(odd_w_out, 1024, 1024, r, W_OUT1, 1024, 0, scr, lane); continue; } r -= 512;
        if (r < 128) { thin::tr_matrix_item(glu_w, 512, 512, r, W_GLU, 512, 0, scr, lane); continue; } r -= 128;
        thin::fold_item(pool_w, pool_scale, even_w_out, r, W_OUT0, lane); }
      for (int idx = gw * 64 + lane; idx < 8192; idx += ngw * 64) WF[idx] = odd_w_in[(size_t)(idx & 1023) * 2056 + 2048 + (idx >> 10)];
      for (int idx = gw * 64 + lane; idx < 65536; idx += ngw * 64) { const int layer = idx >> 15, r = idx & 32767, e = r >> 10, k = r & 1023; WRT[idx] = (bf16_t)(pk2(router_w[layer * 32768 + k * 32 + e], 0.f) & 0xffffu); } }
    GSYNC_CG();
    { PH_BEGIN
      for (int t = gw; t < T_TOK; t += ngw) thin::mod_row(x_in + (size_t)t * DM, MODV + (0 * 2 + t / SEQ) * 3072, HB + (size_t)t * DM, lane); }
    { PH_BEGIN
      LAS float* scr = (LAS float*)(lds + wid * 8448);
      for (int it = gw; it < 98304; it += ngw) {
        if (it < 65536) { const int le = it >> 10, r = it & 1023; thin::tr_gu_item(exp_w_gu + (size_t)le * 2097152, r, W_GU + (size_t)le * 2097152, scr, lane); }
        else { const int r0 = it - 65536, le = r0 >> 9, r = r0 & 511; thin::tr_matrix_item(exp_w_down + (size_t)le * 1048576, 1024, 1024, r, W_DN + (size_t)le * 1048576, 1024, 0, scr, lane); } } }
    GSYNC();
    layer_body<0>(lds);
    GSYNC();
    layer_body<1>(lds);
}
#undef PH_BEGIN
#undef GSYNC
#undef GSYNC_CG
#undef IN
#undef WSP
#undef x_in
#undef cvec
#undef mod_w
#undef mod_b
#undef ln_g
#undef ln_b
#undef even_w_in
#undef pool_w
#undef pool_scale
#undef rel_bias
#undef even_w_out
#undef odd_w_in
#undef forget_b
#undef lam_re
#undef lam_im
#undef log_dt
#undef b_re
#undef b_im
#undef c_re
#undef c_im
#undef d_skip
#undef glu_w
#undef glu_b
#undef odd_w_out
#undef router_w
#undef router_b
#undef exp_w_gu
#undef exp_b_gu
#undef exp_w_down
#undef exp_b_down
#undef ctl
#undef MODV
#undef WF
#undef WRT
#undef W_IN0
#undef W_OUT0
#undef W_IN1
#undef W_OUT1
#undef W_GLU
#undef PSTART
#undef TILE_E
#undef W_GU
#undef W_DN
#undef HB
#undef Z
#undef CAT
#undef Y
#undef X1
#undef X2
#undef H2
#undef XG
#undef YP
#undef ACT
#undef TOP_E
#undef GATES
#undef POS
#undef SLOT
#undef FL
#undef F2
#undef SLOC
#undef YG
static bool launch_mega(void* const* d_in, void* d_out, void* d_ws, size_t ws_size, hipStream_t stream) {
    static int grid = 0;
    if (grid == 0) {
        int dev = 0, cus = 0, per_cu = 0;
        if (ws_size < WS_END) { fprintf(stderr, "kernel_launch: workspace too small (%zu < %zu)\n", ws_size, (size_t)WS_END); grid = -1; return false; }
        if (hipGetDevice(&dev) != hipSuccess || hipDeviceGetAttribute(&cus, hipDeviceAttributeMultiprocessorCount, dev) != hipSuccess) { grid = -1; return false; }
        if (hipFuncSetAttribute((const void*)mega_fwd, hipFuncAttributeMaxDynamicSharedMemorySize, LDS_BYTES) != hipSuccess) { fprintf(stderr, "kernel_launch: hipFuncSetAttribute failed\n"); grid = -1; return false; }
        if (hipOccupancyMaxActiveBlocksPerMultiprocessor(&per_cu, (const void*)mega_fwd, 512, LDS_BYTES) != hipSuccess || per_cu < 1) { fprintf(stderr, "kernel_launch: occupancy query says %d blocks per CU\n", per_cu); grid = -1; return false; }
        (void)hipGetLastError();
        grid = cus;
        if (grid != 256) { fprintf(stderr, "kernel_launch: built for a 256-CU device, found %d CUs\n", cus); grid = -1; return false; }
    }
    if (grid < 0) return false;
    (void)hipMemsetAsync((char*)d_ws + WS_CTL, 0, CTL_BYTES, stream);
    Params p{};
    for (int i = 0; i < 30; ++i) p.in[i] = (const float*)d_in[i];
    p.out = (float*)d_out; p.ws = (unsigned char*)d_ws;
    void* args[] = {&p};
    hipError_t e = hipLaunchCooperativeKernel((const void*)mega_fwd, dim3(grid), dim3(512), args, LDS_BYTES, stream);
    if (e != hipSuccess) { fprintf(stderr, "cooperative launch failed: %s (grid %d)\n", hipGetErrorString(e), grid); return false; }
    return true;
}
extern "C" void kernel_launch(void* const* d_in, const int* in_sizes, int n_in, void* d_out, int out_size, void* d_ws, size_t ws_size, hipStream_t stream) {
    launch_mega(d_in, d_out, d_ws, ws_size, stream);
}
```

```cpp
#include <hip/hip_runtime.h>
#include <hip/hip_cooperative_groups.h>
#include <cstdio>
#include <cstdint>
#include <cstring>
#include <cmath>
#define LAS __attribute__((address_space(3)))
#define GAS __attribute__((address_space(1)))
typedef unsigned short bf16_t;
typedef short bf16x8 __attribute__((ext_vector_type(8)));
typedef short s16x4 __attribute__((ext_vector_type(4)));
typedef float f32x4 __attribute__((ext_vector_type(4)));
typedef float f32x2 __attribute__((ext_vector_type(2)));
typedef float f32x16 __attribute__((ext_vector_type(16)));
typedef unsigned u32x4 __attribute__((ext_vector_type(4)));
typedef unsigned u32x2 __attribute__((ext_vector_type(2)));
typedef __bf16 bf16x2_t __attribute__((ext_vector_type(2)));

constexpr int T_TOK = 16384, SEQ = 8192, DM = 1024, NBATCH = 2;
constexpr int ZP = 2048;
constexpr int MAXROWS = 73728;
constexpr int MAXTILES = MAXROWS / 256;
constexpr float DN_ALPHA = 1.41421356237309515f;
constexpr float LN_EPS = 1e-5f;
constexpr float LOG2E = 1.4426950408889634f;
constexpr float QSCALE = 0.125f * 1.4426950408889634f;

__device__ __forceinline__ unsigned pk2(float lo, float hi) { f32x2 v = {lo, hi}; bf16x2_t b = __builtin_convertvector(v, bf16x2_t); return __builtin_bit_cast(unsigned, b); }
__device__ __forceinline__ float bf2f(unsigned short u) { return __uint_as_float(((unsigned)u) << 16); }
__device__ __forceinline__ float bflo(unsigned w) { return __uint_as_float(w << 16); }
__device__ __forceinline__ float bfhi(unsigned w) { return __uint_as_float(w & 0xffff0000u); }
__device__ __forceinline__ float wave_sum(float v) {
#pragma unroll
    for (int o = 1; o < 64; o <<= 1) v += __shfl_xor(v, o);
    return v;
}
__device__ __forceinline__ float fast_sigmoid(float x) { return __builtin_amdgcn_rcpf(1.f + __builtin_amdgcn_exp2f(-x * LOG2E)); }
#define LDS_WAIT() asm volatile("s_waitcnt lgkmcnt(0)" ::: "memory")
#define VM_WAIT() asm volatile("s_waitcnt vmcnt(0)" ::: "memory")
namespace pg8 {
#define PG8_LAS __attribute__((address_space(3)))
typedef unsigned short bf16_t;
typedef short bf16x8 __attribute__((ext_vector_type(8)));
typedef float f32x4 __attribute__((ext_vector_type(4)));
typedef unsigned u32x4 __attribute__((ext_vector_type(4)));
constexpr int BM = 256, BK = 64, HALF = 128, HTB = HALF * BK * 2  , STAGE_BYTES = 8 * HTB, NXCD = 8, WGM = 8;

__host__ __device__ __forceinline__ int lds_byte(int r, int c) { const int st = (r >> 4) * 2 + (c >> 5), rr = r & 15, cc = c & 31, ob = rr * 64 + cc * 2; return st * 1024 + (ob ^ (((ob >> 9) & 1) << 5)); }
__host__ __device__ __forceinline__ void stage_rc(int b, int& R, int& C) { const int st = b / 1024, sb = b % 1024, swz = sb ^ (((sb >> 9) & 1) << 5); R = (st >> 1) * 16 + swz / 64; C = (st & 1) * 32 + (swz % 64) / 2; }
__host__ __device__ __forceinline__ int perm32(int rho) { const int n = rho >> 4, i = rho & 15; return 8 * (i >> 2) + 4 * n + (i & 3); }

struct Unit { int pm, pn, e; size_t boff; };
struct Gemm { const bf16_t* A; const bf16_t* Bt; int M, N, K; };

struct StaticOrder {
    int nM, nN, nwg, G, c;
    __host__ __device__ void init(int M, int N, int G_, int c_) { nM = M / BM; nN = N / BM; nwg = nM * nN; G = G_; c = c_; }
    __host__ __device__ bool next(int i, Unit& u) const {
        const long L = (long)i * G + c; if (L >= nwg) return false;
        int wgid = (int)L; { const int q = nwg / NXCD, r = nwg % NXCD, xcd = wgid % NXCD, off = wgid / NXCD; wgid = (xcd < r ? xcd * (q + 1) : r * (q + 1) + (xcd - r) * q) + off; }
        const int nig = WGM * nN, gid = wgid / nig, fm = gid * WGM, gsz = (nM - fm) < WGM ? (nM - fm) : WGM;
        u.pm = fm + ((wgid % nig) % gsz); u.pn = (wgid % nig) / gsz; u.e = 0; u.boff = 0; return true;
    }
    __device__ __forceinline__ void a_ready(const Unit&) const {}
    __device__ __forceinline__ void done(const Unit&) const {}
};

__device__ __forceinline__ unsigned cvt_pk_bf16(float lo, float hi) { unsigned r; asm volatile("v_cvt_pk_bf16_f32 %0, %1, %2" : "=v"(r) : "v"(lo), "v"(hi)); return r; }
typedef float f32x2 __attribute__((ext_vector_type(2)));

template <class Epi, class Sched, bool ALIGN_EPI = false, bool SP2 = false>
__device__ __forceinline__ void gemm_phase(PG8_LAS unsigned char* lds, const Gemm g, const Sched& S, const Epi& E, const int tid) {
    const int wid = __builtin_amdgcn_readfirstlane(tid >> 6), lane = tid & 63, wr = wid >> 2, wc = wid & 3, fr = lane & 15, fq = lane >> 4;
    const int K = g.K, nt = K / BK;
    unsigned voffA[2], voffB[2];
#pragma unroll
    for (int i = 0; i < 2; ++i) { int R, C; stage_rc(tid * 16 + i * 8192, R, C); const int Rb = Epi::PERM ? ((R & ~31) + perm32(R & 31)) : R;
        voffA[i] = (unsigned)(R * K + C) * 2u; voffB[i] = (unsigned)(Rb * K + C) * 2u; }
    const size_t kstep = (size_t)(BK * 2);
    const size_t hstep = (size_t)HALF * K * 2;
    const size_t tstep = 2 * hstep;
    const unsigned ldsw = (unsigned)wid * 1024u;
    const int aoff = lds_byte(wr * 64 + fr, fq * 8), boff = lds_byte(wc * 32 + fr, fq * 8);
#define PG8_SA(b, h) (((b) * 2 + (h)) * HTB)
#define PG8_SB(b, h) ((4 + (b) * 2 + (h)) * HTB)
#define PG8_STAGE(bufoff, gbase, voff) do { _Pragma("unroll") for (int _i = 0; _i < 2; ++_i) \
        __builtin_amdgcn_global_load_lds((const unsigned*)((const char*)(gbase) + (voff)[_i]), (PG8_LAS unsigned*)(lds + (bufoff) + ldsw + _i * 8192), 16, 0, 0); } while (0)
#define PG8_LDA(dst, b, h) do { _Pragma("unroll") for (int m = 0; m < 4; ++m) _Pragma("unroll") for (int k = 0; k < 2; ++k) dst[m][k] = *(const PG8_LAS bf16x8*)(lds + PG8_SA(b, h) + aoff + m * 2048 + k * 1024); } while (0)
#define PG8_LDB(dst, b, h) do { _Pragma("unroll") for (int n = 0; n < 2; ++n) _Pragma("unroll") for (int k = 0; k < 2; ++k) dst[n][k] = *(const PG8_LAS bf16x8*)(lds + PG8_SB(b, h) + boff + n * 2048 + k * 1024); } while (0)
#define PG8_MMA(ai, bj, At, Bt) do { __builtin_amdgcn_s_setprio(1); _Pragma("unroll") for (int m = 0; m < 4; ++m) _Pragma("unroll") for (int n = 0; n < 2; ++n) _Pragma("unroll") for (int k = 0; k < 2; ++k) \
        acc[ai][bj][m][n] = __builtin_amdgcn_mfma_f32_16x16x32_bf16(Bt[n][k], At[m][k], acc[ai][bj][m][n], 0, 0, 0); __builtin_amdgcn_s_setprio(0); } while (0)
#define PG8_WAIT_V(n) asm volatile("s_waitcnt vmcnt(" #n ")" ::: "memory")
#define PG8_WAIT_L(n) asm volatile("s_waitcnt lgkmcnt(" #n ")" ::: "memory")
#define PG8_BAR __builtin_amdgcn_s_barrier()
#define PG8_SCHED __builtin_amdgcn_sched_barrier(0)
    Unit cur, nxt; int ui = 0;
    if (!S.next(0, cur)) return;
    f32x4 acc[2][2][4][2];
#pragma unroll
    for (int a = 0; a < 2; ++a)
#pragma unroll
        for (int b = 0; b < 2; ++b)
#pragma unroll
            for (int m = 0; m < 4; ++m)
#pragma unroll
                for (int n = 0; n < 2; ++n) acc[a][b][m][n] = (f32x4){0.f, 0.f, 0.f, 0.f};
    bf16x8 At[4][2], B0[2][2], B1[2][2];
    const char* cA = (const char*)g.A + (size_t)cur.pm * tstep; const char* cB = (const char*)g.Bt + cur.boff + (size_t)cur.pn * tstep;
    S.a_ready(cur);
    if constexpr (SP2) {
        PG8_STAGE(PG8_SB(0, 0), cB, voffB); PG8_STAGE(PG8_SB(0, 1), cB + hstep, voffB); PG8_STAGE(PG8_SA(0, 0), cA, voffA); PG8_STAGE(PG8_SA(0, 1), cA + hstep, voffA);
        if (wr == 1) PG8_BAR;
        PG8_WAIT_V(2); PG8_BAR;
        PG8_STAGE(PG8_SB(1, 0), cB + kstep, voffB); PG8_STAGE(PG8_SA(1, 0), cA + kstep, voffA); PG8_STAGE(PG8_SB(1, 1), cB + hstep + kstep, voffB);
        PG8_WAIT_V(6); PG8_BAR;
    } else {
        PG8_STAGE(PG8_SB(0, 0), cB, voffB); PG8_STAGE(PG8_SA(0, 0), cA, voffA); PG8_STAGE(PG8_SB(0, 1), cB + hstep, voffB); PG8_STAGE(PG8_SA(0, 1), cA + hstep, voffA);
        if (wr == 1) PG8_BAR;
        PG8_WAIT_V(4); PG8_BAR;
        PG8_STAGE(PG8_SB(1, 0), cB + kstep, voffB); PG8_STAGE(PG8_SA(1, 0), cA + kstep, voffA); PG8_STAGE(PG8_SB(1, 1), cB + hstep + kstep, voffB);
        PG8_WAIT_V(6); PG8_BAR;
    }
    for (;;) {
        const bool has_next = S.next(ui + 1, nxt);
        const char* nA = has_next ? (const char*)g.A + (size_t)nxt.pm * tstep : cA; const char* nB = has_next ? (const char*)g.Bt + nxt.boff + (size_t)nxt.pn * tstep : cB;
        for (int t = 0; t < nt; t += 2) {
            const bool last = (t == nt - 2);
            const char* a1 = cA + (size_t)(t + 1) * kstep;
            const char* a2 = last ? nA : cA + (size_t)(t + 2) * kstep; const char* b2 = last ? nB : cB + (size_t)(t + 2) * kstep;
            const char* a3 = a2 + kstep; const char* b3 = b2 + kstep;
            if (last && has_next) S.a_ready(nxt);
            if constexpr (SP2) {
            PG8_LDB(B0, 0, 0); PG8_LDB(B1, 0, 1); PG8_SCHED; PG8_LDA(At, 0, 0); PG8_STAGE(PG8_SA(1, 1), a1 + hstep, voffA);
            PG8_WAIT_V(8); PG8_WAIT_L(0); PG8_BAR; PG8_MMA(0, 0, At, B0); PG8_MMA(0, 1, At, B1); PG8_BAR; PG8_SCHED;
            PG8_LDA(At, 0, 1); PG8_STAGE(PG8_SB(0, 0), b2, voffB); PG8_STAGE(PG8_SB(0, 1), b2 + hstep, voffB); PG8_STAGE(PG8_SA(0, 0), a2, voffA);
            PG8_WAIT_V(8); PG8_WAIT_L(0); PG8_BAR; PG8_MMA(1, 0, At, B0); PG8_MMA(1, 1, At, B1); PG8_BAR; PG8_SCHED;
            PG8_LDB(B0, 1, 0); PG8_LDB(B1, 1, 1); PG8_SCHED; PG8_LDA(At, 1, 0); PG8_STAGE(PG8_SA(0, 1), a2 + hstep, voffA);
            PG8_WAIT_V(8); PG8_WAIT_L(0); PG8_BAR; PG8_MMA(0, 0, At, B0); PG8_MMA(0, 1, At, B1); PG8_BAR; PG8_SCHED;
            PG8_LDA(At, 1, 1); PG8_STAGE(PG8_SB(1, 0), b3, voffB); PG8_STAGE(PG8_SB(1, 1), b3 + hstep, voffB); PG8_STAGE(PG8_SA(1, 0), a3, voffA);
            PG8_WAIT_V(8); PG8_WAIT_L(0); PG8_BAR; PG8_MMA(1, 0, At, B0); PG8_MMA(1, 1, At, B1); PG8_BAR; PG8_SCHED;
            } else {
            PG8_LDB(B0, 0, 0); PG8_SCHED; PG8_LDA(At, 0, 0); PG8_STAGE(PG8_SA(1, 1), a1 + hstep, voffA);
            PG8_WAIT_L(8); PG8_BAR; PG8_WAIT_L(0); PG8_MMA(0, 0, At, B0); PG8_BAR; PG8_SCHED;
            PG8_LDB(B1, 0, 1); PG8_STAGE(PG8_SB(0, 0), b2, voffB);
            PG8_BAR; PG8_WAIT_L(0); PG8_MMA(0, 1, At, B1); PG8_BAR;
            PG8_LDA(At, 0, 1); PG8_STAGE(PG8_SA(0, 0), a2, voffA);
            PG8_BAR; PG8_WAIT_L(0); PG8_MMA(1, 0, At, B0); PG8_BAR; PG8_SCHED;
            PG8_STAGE(PG8_SB(0, 1), b2 + hstep, voffB);
            PG8_WAIT_V(6); PG8_BAR; PG8_MMA(1, 1, At, B1); PG8_BAR;
            PG8_LDB(B0, 1, 0); PG8_SCHED; PG8_LDA(At, 1, 0); PG8_STAGE(PG8_SA(0, 1), a2 + hstep, voffA);
            PG8_WAIT_L(8); PG8_BAR; PG8_WAIT_L(0); PG8_MMA(0, 0, At, B0); PG8_BAR; PG8_SCHED;
            PG8_LDB(B1, 1, 1); PG8_STAGE(PG8_SB(1, 0), b3, voffB);
            PG8_BAR; PG8_WAIT_L(0); PG8_MMA(0, 1, At, B1); PG8_BAR;
            PG8_LDA(At, 1, 1); PG8_STAGE(PG8_SA(1, 0), a3, voffA);
            PG8_BAR; PG8_WAIT_L(0); PG8_MMA(1, 0, At, B0); PG8_BAR; PG8_SCHED;
            PG8_STAGE(PG8_SB(1, 1), b3 + hstep, voffB);
            PG8_WAIT_V(6); PG8_BAR; PG8_MMA(1, 1, At, B1); PG8_BAR;
            }
        }
        if constexpr (ALIGN_EPI) { if (wr == 0) PG8_BAR; }
        if constexpr (!Epi::AFTER_DRAIN) { E(acc, cur, wr, wc, fr, fq); S.done(cur); }
        if (!has_next) break;
#pragma unroll
        for (int a = 0; a < 2; ++a)
#pragma unroll
            for (int b = 0; b < 2; ++b)
#pragma unroll
                for (int m = 0; m < 4; ++m)
#pragma unroll
                    for (int n = 0; n < 2; ++n) acc[a][b][m][n] = (f32x4){0.f, 0.f, 0.f, 0.f};
        cur = nxt; cA = nA; cB = nB; ++ui;
        if constexpr (ALIGN_EPI) { if (wr == 1) PG8_BAR; }
    }
    PG8_WAIT_V(0);
    if constexpr (!ALIGN_EPI) { if (wr == 0) PG8_BAR; }
    PG8_BAR;
    if constexpr (Epi::AFTER_DRAIN) { E.fused(acc, cur, wr, wc, fr, fq, lds, wid, lane); S.done(cur); }
#undef PG8_SA
#undef PG8_SB
#undef PG8_STAGE
#undef PG8_LDA
#undef PG8_LDB
#undef PG8_MMA
#undef PG8_WAIT_V
#undef PG8_WAIT_L
#undef PG8_BAR
#undef PG8_SCHED
}
}

#ifndef PG8_SP2
#define PG8_SP2 true
#endif
#ifndef PG8_ALIGN
#define PG8_ALIGN true
#endif
namespace epi {
using pg8::Unit; using pg8::BM; using pg8::HALF;

struct EpiZ {
    static constexpr bool PERM = true, AFTER_DRAIN = false;
    bf16_t* O; int ldc; int sc_lo, sc_hi; float sc;
    __device__ __forceinline__ void operator()(const f32x4 (&acc)[2][2][4][2], const Unit& u, int wr, int wc, int fr, int fq) const {
        const int row0 = u.pm * BM + wr * 64 + fr; const int colt = u.pn * BM;
        const float s = (colt >= sc_lo && colt < sc_hi) ? sc : 1.f;
        const int col0 = colt + wc * 32 + 8 * fq;
#pragma unroll
        for (int ai = 0; ai < 2; ++ai)
#pragma unroll
            for (int m = 0; m < 4; ++m) { bf16_t* rowp = O + (size_t)(row0 + ai * HALF + m * 16) * ldc + col0;
#pragma unroll
                for (int bj = 0; bj < 2; ++bj) { const f32x4 v0 = acc[ai][bj][m][0] * s, v1 = acc[ai][bj][m][1] * s;
                    u32x4 w; w.x = pk2(v0[0], v0[1]); w.y = pk2(v0[2], v0[3]); w.z = pk2(v1[0], v1[1]); w.w = pk2(v1[2], v1[3]);
                    *(u32x4*)(rowp + bj * HALF) = w; } }
    }
};
struct EpiF32 {
    static constexpr bool PERM = false, AFTER_DRAIN = false;
    float* O; int ldc;
    __device__ __forceinline__ void operator()(const f32x4 (&acc)[2][2][4][2], const Unit& u, int wr, int wc, int fr, int fq) const {
        const int row0 = u.pm * BM + wr * 64 + fr; const int col0 = u.pn * BM + wc * 32 + 4 * fq;
#pragma unroll
        for (int ai = 0; ai < 2; ++ai)
#pragma unroll
            for (int m = 0; m < 4; ++m) { float* rowp = O + (size_t)(row0 + ai * HALF + m * 16) * ldc + col0;
#pragma unroll
                for (int bj = 0; bj < 2; ++bj)
#pragma unroll
                    for (int n = 0; n < 2; ++n) *(f32x4*)(rowp + bj * HALF + n * 16) = acc[ai][bj][m][n]; }
    }
};
struct EpiSwiglu {
    static constexpr bool PERM = true, AFTER_DRAIN = false;
    bf16_t* O; const float* bias;
    __device__ __forceinline__ void operator()(const f32x4 (&acc)[2][2][4][2], const Unit& u, int wr, int wc, int fr, int fq) const {
        const int row0 = u.pm * BM + wr * 64 + fr; const int cc = u.pn * 128 + wc * 32 + 8 * fq;
        const float* bg = bias + (size_t)u.e * 2048 + cc; const float* bu = bg + 1024;
        const f32x4 bg0 = *(const f32x4*)bg, bg1 = *(const f32x4*)(bg + 4), bu0 = *(const f32x4*)bu, bu1 = *(const f32x4*)(bu + 4);
#pragma unroll
        for (int ai = 0; ai < 2; ++ai)
#pragma unroll
            for (int m = 0; m < 4; ++m) {
                float r[8];
#pragma unroll
                for (int n = 0; n < 2; ++n) { const f32x4 g4 = acc[ai][0][m][n] + (n ? bg1 : bg0), u4 = acc[ai][1][m][n] + (n ? bu1 : bu0);
#pragma unroll
                    for (int i = 0; i < 4; ++i) { const float gate = fminf(g4[i], 7.0f); const float up = fminf(fmaxf(u4[i], -7.0f), 7.0f);
                        const float glu = gate * __builtin_amdgcn_rcpf(1.f + __builtin_amdgcn_exp2f(-1.702f * LOG2E * gate)); r[n * 4 + i] = (up + 1.0f) * glu; } }
                u32x4 w; w.x = pk2(r[0], r[1]); w.y = pk2(r[2], r[3]); w.z = pk2(r[4], r[5]); w.w = pk2(r[6], r[7]);
                *(u32x4*)(O + (size_t)(row0 + ai * HALF + m * 16) * 1024 + cc) = w; }
    }
};
struct EpiBiasBf16 {
    static constexpr bool PERM = true, AFTER_DRAIN = false;
    bf16_t* O; const float* bias;
    __device__ __forceinline__ void operator()(const f32x4 (&acc)[2][2][4][2], const Unit& u, int wr, int wc, int fr, int fq) const {
        const int row0 = u.pm * BM + wr * 64 + fr; const int col0 = u.pn * BM + wc * 32 + 8 * fq;
        const float* bp = bias + (size_t)u.e * 1024 + col0;
#pragma unroll
        for (int bj = 0; bj < 2; ++bj) { const f32x4 b0 = *(const f32x4*)(bp + bj * HALF), b1 = *(const f32x4*)(bp + bj * HALF + 4);
#pragma unroll
            for (int ai = 0; ai < 2; ++ai)
#pragma unroll
                for (int m = 0; m < 4; ++m) { const f32x4 v0 = acc[ai][bj][m][0] + b0, v1 = acc[ai][bj][m][1] + b1;
                    u32x4 w; w.x = pk2(v0[0], v0[1]); w.y = pk2(v0[2], v0[3]); w.z = pk2(v1[0], v1[1]); w.w = pk2(v1[2], v1[3]);
                    *(u32x4*)(O + (size_t)(row0 + ai * HALF + m * 16) * 1024 + col0 + bj * HALF) = w; } }
    }
};
struct EpiGlu {
    static constexpr bool PERM = true, AFTER_DRAIN = false;
    bf16_t* O; const bf16_t* YG; const float* bias;
    __device__ __forceinline__ void operator()(const f32x4 (&acc)[2][2][4][2], const Unit& u, int wr, int wc, int fr, int fq) const {
        const int row0 = u.pm * BM + wr * 64 + fr; const int col0 = u.pn * BM + wc * 32 + 8 * fq;
#pragma unroll
        for (int bj = 0; bj < 2; ++bj) { const f32x4 b0 = *(const f32x4*)(bias + col0 + bj * HALF), b1 = *(const f32x4*)(bias + col0 + bj * HALF + 4);
#pragma unroll
            for (int ai = 0; ai < 2; ++ai)
#pragma unroll
                for (int m = 0; m < 4; ++m) { const size_t row = (size_t)(row0 + ai * HALF + m * 16);
                    const u32x4 y = *(const u32x4*)(YG + row * 512 + col0 + bj * HALF);
                    const f32x4 v0 = acc[ai][bj][m][0] + b0, v1 = acc[ai][bj][m][1] + b1;
                    u32x4 w;
                    w.x = pk2(bflo(y.x) * fast_sigmoid(v0[0]), bfhi(y.x) * fast_sigmoid(v0[1])); w.y = pk2(bflo(y.y) * fast_sigmoid(v0[2]), bfhi(y.y) * fast_sigmoid(v0[3]));
                    w.z = pk2(bflo(y.z) * fast_sigmoid(v1[0]), bfhi(y.z) * fast_sigmoid(v1[1])); w.w = pk2(bflo(y.w) * fast_sigmoid(v1[2]), bfhi(y.w) * fast_sigmoid(v1[3]));
                    *(u32x4*)(O + row * 1024 + col0 + bj * HALF) = w; } }
    }
};
struct MoeOrder {
    int R, ncol, c; const int* tile_e; size_t estride;
    __device__ bool next(int i, Unit& u) const {
        const int xcd = c & 7, j = c >> 3, rp = 32 / ncol;
        const int rt = (i * 8 + xcd) * rp + j / ncol; if (rt >= R) return false;
        u.pm = rt; u.pn = j % ncol; u.e = tile_e[rt]; u.boff = (size_t)u.e * estride; return true;
    }
    __device__ __forceinline__ void a_ready(const Unit&) const {}
    __device__ __forceinline__ void done(const Unit&) const {}
};
}
namespace att {
constexpr int SLOTB = 8192;
constexpr int L_K = 0, L_V = 2 * SLOTB, L_WS = 4 * SLOTB, L_OST = L_WS + 8 * 64 * 4, L_FK = L_OST + 8 * 4096, L_TAB = L_FK + 8192 * 4, L_END = L_TAB + 272 * 4;
__device__ __forceinline__ int crow(int r, int hi) { return (r & 3) + 8 * (r >> 2) + 4 * hi; }
#define SBAR() __builtin_amdgcn_sched_barrier(0)
__device__ __forceinline__ void glds16(const void* gsrc, unsigned lds_dst) { unsigned keep;
    asm volatile("s_mov_b32 %0, m0\n\ts_mov_b32 m0, %2\n\ts_nop 0\n\tglobal_load_lds_dwordx4 %1, off\n\ts_mov_b32 m0, %0" : "=&s"(keep) : "v"(gsrc), "s"(lds_dst) : "memory"); }
#define WAIT_BAR0() asm volatile("s_waitcnt vmcnt(0) lgkmcnt(0)\n\ts_barrier" ::: "memory")
__device__ __forceinline__ void qkt(f32x16& p0, f32x16& p1, const LAS char* Kslot, const bf16x8* qr, int r32, int hi) {
    const LAS char* kb = Kslot + hi * 1024 + r32 * 16;
    const f32x16 z = {};
#pragma unroll
    for (int d0 = 0; d0 < 4; ++d0) {
        const bf16x8 b0 = *(const LAS bf16x8*)(kb + d0 * 2048);
        const bf16x8 b1 = *(const LAS bf16x8*)(kb + d0 * 2048 + 512);
        if (d0 == 0) { p0 = __builtin_amdgcn_mfma_f32_32x32x16_bf16(b0, qr[0], z, 0, 0, 0); p1 = __builtin_amdgcn_mfma_f32_32x32x16_bf16(b1, qr[0], z, 0, 0, 0); }
        else { p0 = __builtin_amdgcn_mfma_f32_32x32x16_bf16(b0, qr[d0], p0, 0, 0, 0); p1 = __builtin_amdgcn_mfma_f32_32x32x16_bf16(b1, qr[d0], p1, 0, 0, 0); } }
}
__device__ __forceinline__ float rowmax(const f32x16& p0, const f32x16& p1) {
    float a = fmaxf(fmaxf(p0[0], p0[1]), p1[0]), b = fmaxf(fmaxf(p0[2], p0[3]), p1[1]); a = fmaxf(fmaxf(a, p1[2]), p1[3]);
#pragma unroll
    for (int r = 4; r < 16; r += 4) { a = fmaxf(fmaxf(a, p0[r]), p0[r + 1]); b = fmaxf(fmaxf(b, p0[r + 2]), p0[r + 3]); a = fmaxf(fmaxf(a, p1[r]), p1[r + 1]); b = fmaxf(fmaxf(b, p1[r + 2]), p1[r + 3]); }
    const float m = fmaxf(a, b);
    auto rr = __builtin_amdgcn_permlane32_swap(__float_as_uint(m), __float_as_uint(m), false, false);
    return fmaxf(__uint_as_float(rr[0]), __uint_as_float(rr[1]));
}
__device__ __forceinline__ void pv(f32x16* o, int vb, bf16x8 pa0, bf16x8 pa1, bf16x8 pa2, bf16x8 pa3) {
#pragma unroll
    for (int d0 = 0; d0 < 2; ++d0) { s16x4 lo[4], hi[4];
#pragma unroll
        for (int ks = 0; ks < 4; ++ks) {
            asm volatile("ds_read_b64_tr_b16 %0,%1 offset:%c2" : "=&v"(lo[ks]) : "v"(vb), "i"(d0 * 4096 + ks * 1024) : "memory");
            asm volatile("ds_read_b64_tr_b16 %0,%1 offset:%c2" : "=&v"(hi[ks]) : "v"(vb), "i"(d0 * 4096 + ks * 1024 + 512) : "memory"); }
        asm volatile("s_waitcnt lgkmcnt(0)" ::: "memory"); SBAR();
#define PKV(k) (bf16x8){lo[k][0], lo[k][1], lo[k][2], lo[k][3], hi[k][0], hi[k][1], hi[k][2], hi[k][3]}
        o[d0] = __builtin_amdgcn_mfma_f32_32x32x16_bf16(pa0, PKV(0), o[d0], 0, 0, 0);
        o[d0] = __builtin_amdgcn_mfma_f32_32x32x16_bf16(pa1, PKV(1), o[d0], 0, 0, 0);
        o[d0] = __builtin_amdgcn_mfma_f32_32x32x16_bf16(pa2, PKV(2), o[d0], 0, 0, 0);
        o[d0] = __builtin_amdgcn_mfma_f32_32x32x16_bf16(pa3, PKV(3), o[d0], 0, 0, 0);
#undef PKV
    }
}
template <int MODE>
__device__ __forceinline__ void attn_unit(int b, int h, int qb, int jlo, const bf16_t* Z, bf16_t* CAT, const float* F2bh, const LAS float* segoff, LAS char* shm, const int tid) {
    const int lane = tid & 63, r32 = lane & 31, hi = lane >> 5; const int wid = __builtin_amdgcn_readfirstlane(tid >> 6);
    const long rowbase = (long)b * SEQ; const int q0 = qb * 256;
    const bf16_t* Qw = Z + (rowbase + q0 + wid * 32) * ZP + 512 + h * 64;
    const bf16_t* Kh = Z + rowbase * ZP + 1024 + h * 64; const bf16_t* Vh = Z + rowbase * ZP + 1536 + h * 64;
    const unsigned lds0 = (unsigned)(uintptr_t)shm;
    LAS float* wsf = (LAS float*)(shm + L_WS) + wid * 64;
    const bf16_t* ksrc = Kh + (long)lane * ZP + wid * 8;
    const bf16_t* vsrc = Vh + (long)(16 * (wid & 3) + (lane >> 2)) * ZP + (wid >> 2) * 32 + (lane & 3) * 8;
    const unsigned kdst = lds0 + L_K + wid * 1024, vdst = lds0 + L_V + wid * 1024;
#define DMA_K(t, slot) glds16(ksrc + (long)(t) * 64 * ZP, (unsigned)__builtin_amdgcn_readfirstlane(kdst + (slot)))
#define DMA_V(t, slot) glds16(vsrc + (long)(t) * 64 * ZP, (unsigned)__builtin_amdgcn_readfirstlane(vdst + (slot)))
    const int vb0 = (int)(lds0 + L_V) + ((lane >> 4) & 1) * 32 + (lane & 3) * 8 + (4 * hi + ((lane & 15) >> 2)) * 64;
    const int jhi = 4 * qb + 3;
    int mylo, myhi;
    if (MODE == 0) { const int cw = 4 * qb + (wid >> 1); mylo = cw - 8 < 0 ? 0 : cw - 8; myhi = cw; }
    else { mylo = jlo; myhi = 4 * qb + (wid >> 1); }
    DMA_K(jlo, 0); DMA_V(jlo, 0);
    float fq = 0.f;
    if (MODE == 1) {
        LAS float* fk = (LAS float*)(shm + L_FK); const int cnt = q0 + 256 - 64 * jlo;
        for (int i = tid; i < cnt; i += 512) { const int s = 64 * jlo + i; fk[i] = F2bh[s] + segoff[s >> 9]; }
        { const int s = q0 + wid * 32 + r32; fq = F2bh[s] + segoff[s >> 9]; }
    }
    bf16x8 qr[4];
#pragma unroll
    for (int d0 = 0; d0 < 4; ++d0) qr[d0] = *(const bf16x8*)(Qw + (long)r32 * ZP + d0 * 16 + hi * 8);
    float m = -1e30f, l = 0.f; f32x16 o[2]; o[0] = f32x16{}; o[1] = f32x16{};
    const int qs = q0 + wid * 32 + r32;
    int slot = 0;
    for (int j = jlo; j <= jhi; ++j) {
        WAIT_BAR0();
        if (j < jhi) { DMA_K(j + 1, slot ^ SLOTB); DMA_V(j + 1, slot ^ SLOTB); }
        if (j >= mylo && j <= myhi) {
            f32x16 p0, p1;
            qkt(p0, p1, shm + L_K + slot, qr, r32, hi);
            if (MODE == 1) {
                const LAS float* fkl = (const LAS float*)(shm + L_FK) + (j - jlo) * 64 + 4 * hi;
#pragma unroll
                for (int r4 = 0; r4 < 4; ++r4) { const f32x4 a = *(const LAS f32x4*)(fkl + 8 * r4), c = *(const LAS f32x4*)(fkl + 32 + 8 * r4);
#pragma unroll
                    for (int i = 0; i < 4; ++i) { p0[4 * r4 + i] += fq - a[i]; p1[4 * r4 + i] += fq - c[i]; } }
                if (j == myhi) {
                    const int kb = 64 * j + 4 * hi;
#pragma unroll
                    for (int r = 0; r < 16; ++r) { const int kv = kb + (r & 3) + 8 * (r >> 2); if (kv > qs) p0[r] = -INFINITY; if (kv + 32 > qs) p1[r] = -INFINITY; }
                }
            } else {
                const LAS float* tab = (const LAS float*)(shm + L_TAB);
                const int dmin = (q0 + wid * 32) - (64 * j + 63);
                if (dmin >= 128) { const float c = tab[256];
#pragma unroll
                    for (int r = 0; r < 16; ++r) { p0[r] += c; p1[r] += c; } }
                else { const int base = qs - 64 * j - 4 * hi + 128;
#pragma unroll
                    for (int r = 0; r < 16; ++r) { int i0 = base - ((r & 3) + 8 * (r >> 2)); int i1 = i0 - 32;
                        i0 = i0 < 0 ? 0 : (i0 > 256 ? 256 : i0); i1 = i1 < 0 ? 0 : (i1 > 256 ? 256 : i1);
                        p0[r] += tab[i0]; p1[r] += tab[i1]; } }
            }
            const float rm = rowmax(p0, p1);
            const float mn = fmaxf(m, rm); const float alpha = __builtin_amdgcn_exp2f(m - mn); m = mn;
            float s0 = 0.f, s1 = 0.f;
#pragma unroll
            for (int r = 0; r < 16; ++r) { p0[r] = __builtin_amdgcn_exp2f(p0[r] - mn); p1[r] = __builtin_amdgcn_exp2f(p1[r] - mn); s0 += p0[r]; s1 += p1[r]; }
            l = l * alpha + (s0 + s1);
            if (hi == 0) wsf[r32] = alpha;
            LDS_WAIT();
#pragma unroll
            for (int r4 = 0; r4 < 4; ++r4) { const f32x4 a = *(const LAS f32x4*)(wsf + 8 * r4 + 4 * hi);
#pragma unroll
                for (int i = 0; i < 4; ++i) { o[0][4 * r4 + i] *= a[i]; o[1][4 * r4 + i] *= a[i]; } }
            u32x4 pw0, pw1, pw2, pw3;
            pw0 = (u32x4){pk2(p0[0], p0[1]), pk2(p0[2], p0[3]), pk2(p0[4], p0[5]), pk2(p0[6], p0[7])};
            pw1 = (u32x4){pk2(p0[8], p0[9]), pk2(p0[10], p0[11]), pk2(p0[12], p0[13]), pk2(p0[14], p0[15])};
            pw2 = (u32x4){pk2(p1[0], p1[1]), pk2(p1[2], p1[3]), pk2(p1[4], p1[5]), pk2(p1[6], p1[7])};
            pw3 = (u32x4){pk2(p1[8], p1[9]), pk2(p1[10], p1[11]), pk2(p1[12], p1[13]), pk2(p1[14], p1[15])};
            SBAR();
            pv(o, vb0 + slot, __builtin_bit_cast(bf16x8, pw0), __builtin_bit_cast(bf16x8, pw1), __builtin_bit_cast(bf16x8, pw2), __builtin_bit_cast(bf16x8, pw3));
        }
        slot ^= SLOTB;
    }
    { auto rr = __builtin_amdgcn_permlane32_swap(__float_as_uint(l), __float_as_uint(l), false, false); l = __uint_as_float(rr[0]) + __uint_as_float(rr[1]); }
    if (hi == 0) wsf[32 + r32] = l;
    LDS_WAIT();
    float rli[16];
#pragma unroll
    for (int r = 0; r < 16; ++r) rli[r] = __builtin_amdgcn_rcpf(wsf[32 + crow(r, hi)]);
    bf16_t* Ow = CAT + (rowbase + q0 + wid * 32) * 1024 + 512 + h * 64;
    { LAS bf16_t* stg = (LAS bf16_t*)(shm + L_OST) + wid * 2048;
#pragma unroll
        for (int r = 0; r < 16; ++r) { const int orow = crow(r, hi);
#pragma unroll
            for (int d0 = 0; d0 < 2; ++d0) stg[orow * 64 + d0 * 32 + r32] = (bf16_t)(pk2(o[d0][r] * rli[r], 0.f) & 0xffffu); }
        LDS_WAIT();
#pragma unroll
        for (int i = 0; i < 4; ++i) { const int row = i * 8 + (lane >> 3), ch = lane & 7; const u32x4 v = *(const LAS u32x4*)(stg + row * 64 + ch * 8); *(u32x4*)(Ow + (long)row * 1024 + ch * 8) = v; } }
    asm volatile("s_waitcnt lgkmcnt(0)\n\ts_barrier" ::: "memory");
#undef DMA_K
#undef DMA_V
}
#undef SBAR
#undef WAIT_BAR0
}
namespace thin {
using att::crow;
__device__ __forceinline__ void ada_mod(const float* c, const float* mod_w, const float* mod_b, float* modv, LAS unsigned char* lds, int tid, int lane, int wid) {
    LAS float* sc = (LAS float*)lds;
    LAS float* part = sc + 2048;
    for (int i = tid; i < 2048; i += 512) { const float v = c[i]; sc[i] = v / (1.f + __expf(-v)); }
    __syncthreads();
    for (int item = blockIdx.x; item < 192; item += gridDim.x) {
        const int lj = item / 48, cg = item % 48, n = cg * 64 + lane;
        const float* w = mod_w + (size_t)lj * 1024 * 3072 + n;
        float a0 = 0.f, a1 = 0.f;
#pragma unroll 16
        for (int kk = 0; kk < 128; ++kk) { const int k = wid * 128 + kk; const float wv = w[(size_t)k * 3072]; a0 += sc[k] * wv; a1 += sc[1024 + k] * wv; }
        part[(wid * 2 + 0) * 64 + lane] = a0; part[(wid * 2 + 1) * 64 + lane] = a1;
        __syncthreads();
        if (wid < 2) { float s = 0.f;
#pragma unroll
            for (int w8 = 0; w8 < 8; ++w8) s += part[(w8 * 2 + wid) * 64 + lane];
            modv[(lj * 2 + wid) * 3072 + n] = s + mod_b[lj * 3072 + n]; }
        __syncthreads();
    }
}
struct TrItem { const float* src; bf16_t* dst; int ldw, ldt; };
__device__ __forceinline__ void tr_load(const TrItem& it, int lane, float (&v)[32]) {
    const float* s = it.src + (size_t)(lane >> 5) * it.ldw + (lane & 31);
#pragma unroll
    for (int i = 0; i < 32; ++i) v[i] = __builtin_nontemporal_load(s + (size_t)(2 * i) * it.ldw);
}
__device__ __forceinline__ void tr_store(const TrItem& it, int lane, const float (&v)[32], LAS float* scr) {
#pragma unroll
    for (int i = 0; i < 32; ++i) scr[(2 * i + (lane >> 5)) * 33 + (lane & 31)] = v[i];
    LDS_WAIT(); asm volatile("" ::: "memory");
    const int c = lane & 7;
#pragma unroll
    for (int j = 0; j < 4; ++j) { const int n = (lane >> 3) + 8 * j; const LAS float* s = scr + (8 * c) * 33 + n;
        u32x4 o; o.x = pk2(s[0 * 33], s[1 * 33]); o.y = pk2(s[2 * 33], s[3 * 33]); o.z = pk2(s[4 * 33], s[5 * 33]); o.w = pk2(s[6 * 33], s[7 * 33]);
        *(u32x4*)(it.dst + (size_t)n * it.ldt + 8 * c) = o; }
    LDS_WAIT(); asm volatile("" ::: "memory");
}
__device__ __forceinline__ TrItem tr_matrix_desc(const float* W, int ldw, int N, int it, bf16_t* WT, int ldt, int dk) {
    const int nblk = N / 32, kb = it / nblk, nb = it % nblk;
    TrItem d; d.src = W + (size_t)(64 * kb) * ldw + 32 * nb; d.dst = WT + (size_t)(32 * nb) * ldt + dk + 64 * kb; d.ldw = ldw; d.ldt = ldt; return d;
}
__device__ __forceinline__ TrItem tr_gu_desc(const float* W, int it, bf16_t* WT) {
    const int kb = it / 64, nb = it % 64, n0 = 32 * nb;
    const int n2 = n0 & 1023; const size_t drow = (size_t)((n2 >> 7) * 256 + (n0 >= 1024 ? 128 : 0) + (n2 & 127));
    TrItem d; d.src = W + (size_t)(64 * kb) * 2048 + n0; d.dst = WT + drow * 1024 + 64 * kb; d.ldw = 2048; d.ldt = 1024; return d;
}
__device__ __forceinline__ void fold_item(const float* pool_w, const float* pool_scale, const float* w_out, int it, bf16_t* WT, int lane) {
    const int kb = it >> 4, nb = it & 15, n = nb * 64 + lane, k0 = kb * 8, g = k0 >> 7;
    float acc[8] = {0.f, 0.f, 0.f, 0.f, 0.f, 0.f, 0.f, 0.f};
    const float* pw = pool_w + (size_t)g * 128 * 128 + (size_t)(k0 & 127) * 128;
#pragma unroll 4
    for (int d = 0; d < 128; ++d) { const float wv = w_out[(size_t)(g * 128 + d) * 1024 + n] * pool_scale[g * 128 + d];
#pragma unroll
        for (int kk = 0; kk < 8; ++kk) acc[kk] += pw[kk * 128 + d] * wv; }
    u32x4 o; o.x = pk2(acc[0], acc[1]); o.y = pk2(acc[2], acc[3]); o.z = pk2(acc[4], acc[5]); o.w = pk2(acc[6], acc[7]);
    *(u32x4*)(WT + (size_t)n * 1024 + k0) = o;
}
__device__ __forceinline__ void mod_row(const float* xrow, const float* mv, bf16_t* orow, int lane) {
#pragma unroll
    for (int j = 0; j < 4; ++j) { const int col = 4 * lane + 256 * j;
        const f32x4 x = *(const f32x4*)(xrow + col), sh = *(const f32x4*)(mv + col), sc = *(const f32x4*)(mv + 1024 + col);
        const f32x4 h = x * (1.f + sc) + sh; u32x2 w; w.x = pk2(h[0], h[1]); w.y = pk2(h[2], h[3]); *(u32x2*)(orow + col) = w; }
}
__device__ __forceinline__ void pool_row(const bf16_t* Z, int t, bf16_t* CAT, int lane) {
    const int s = t & (SEQ - 1), g = lane >> 4, win = 2 << g;
    float acc[8] = {0.f, 0.f, 0.f, 0.f, 0.f, 0.f, 0.f, 0.f}, own[8];
#pragma unroll
    for (int i = 0; i < 16; ++i) {
        if (i < win && s - i >= 0) { const u32x4 w = *(const u32x4*)(Z + (size_t)(t - i) * ZP + 8 * lane);
            const float f[8] = {bflo(w.x), bfhi(w.x), bflo(w.y), bfhi(w.y), bflo(w.z), bfhi(w.z), bflo(w.w), bfhi(w.w)};
#pragma unroll
            for (int q = 0; q < 8; ++q) { acc[q] += f[q]; if (i == 0) own[q] = f[q]; } } }
    const int cnt = (s + 1 < win) ? s + 1 : win; const float inv = 1.f / (float)cnt;
    u32x4 o; o.x = pk2(acc[0] * inv - own[0], acc[1] * inv - own[1]); o.y = pk2(acc[2] * inv - own[2], acc[3] * inv - own[3]);
    o.z = pk2(acc[4] * inv - own[4], acc[5] * inv - own[5]); o.w = pk2(acc[6] * inv - own[6], acc[7] * inv - own[7]);
    *(u32x4*)(CAT + (size_t)t * 1024 + 8 * lane) = o;
}
struct LnrArgs { const float* xres; const float* Y; const float* mvA; const float* mvB; const float* lg; const float* lb; float* X1; bf16_t* H2; const bf16_t* WrT; const float* rb;
                 unsigned* count; int* top_e; float* gates; int* pos; };
__device__ __forceinline__ void lnr_phase(const LnrArgs& a, LAS unsigned char* lds, int tid, int lane, int wid) {
    constexpr int AP = 2064;
    LAS unsigned char* At = lds; LAS float* red = (LAS float*)(lds + 32 * AP); LAS float* lg2 = red + 8 * 32 * 33;
    const int r32 = lane & 31, hi = lane >> 5;
    for (int tile = blockIdx.x; tile < T_TOK / 32; tile += gridDim.x) {
#pragma unroll 1
        for (int q = 0; q < 4; ++q) { const int tl = wid * 4 + q, t = tile * 32 + tl, b = t / SEQ;
            const float* xr = a.xres + (size_t)t * DM; const float* yr = a.Y + (size_t)t * DM; const float* gA = a.mvA + b * 3072 + 2048; const float* mB = a.mvB + b * 3072;
            f32x4 v[4]; float s = 0.f;
#pragma unroll
            for (int j = 0; j < 4; ++j) { const int col = 4 * lane + 256 * j; const f32x4 x = *(const f32x4*)(xr + col), y = *(const f32x4*)(yr + col), g = *(const f32x4*)(gA + col);
                v[j] = DN_ALPHA * x + (1.f + g) * y; s += (v[j][0] + v[j][1]) + (v[j][2] + v[j][3]); }
            const float mean = wave_sum(s) * (1.f / DM); float s2 = 0.f;
#pragma unroll
            for (int j = 0; j < 4; ++j) { v[j] = v[j] - mean; s2 += (v[j][0] * v[j][0] + v[j][1] * v[j][1]) + (v[j][2] * v[j][2] + v[j][3] * v[j][3]); }
            const float rstd = 1.f / sqrtf(wave_sum(s2) * (1.f / DM) + LN_EPS);
#pragma unroll
            for (int j = 0; j < 4; ++j) { const int col = 4 * lane + 256 * j; const f32x4 g = *(const f32x4*)(a.lg + col), bb = *(const f32x4*)(a.lb + col);
                const f32x4 x1 = v[j] * rstd * g + bb; *(f32x4*)(a.X1 + (size_t)t * DM + col) = x1;
                const f32x4 sh = *(const f32x4*)(mB + col), sc = *(const f32x4*)(mB + 1024 + col); const f32x4 h = x1 * (1.f + sc) + sh;
                u32x2 w; w.x = pk2(h[0], h[1]); w.y = pk2(h[2], h[3]);
                *(u32x2*)(a.H2 + (size_t)t * DM + col) = w; *(LAS u32x2*)(At + tl * AP + col * 2) = w; }
        }
        __syncthreads();
        { f32x16 acc = {};
#pragma unroll
            for (int s = 0; s < 8; ++s) { const int kb = 128 * wid + 16 * s + 8 * hi;
                const bf16x8 af = *(const LAS bf16x8*)(At + r32 * AP + kb * 2); const bf16x8 bfr = *(const bf16x8*)(a.WrT + (size_t)r32 * 1024 + kb);
                acc = __builtin_amdgcn_mfma_f32_32x32x16_bf16(af, bfr, acc, 0, 0, 0); }
#pragma unroll
            for (int r = 0; r < 16; ++r) red[(wid * 32 + crow(r, hi)) * 33 + r32] = acc[r]; }
        __syncthreads();
        { const int tok = tid >> 4;
#pragma unroll
            for (int q = 0; q < 2; ++q) { const int e = (tid & 15) * 2 + q; float s = a.rb[e];
#pragma unroll
                for (int w = 0; w < 8; ++w) s += red[(w * 32 + tok) * 33 + e];
                lg2[tok * 33 + e] = s; } }
        __syncthreads();
        if (wid == 0) {
            const bool act = lane < 32; const int tok = lane & 31, t = tile * 32 + tok;
            float v[32];
#pragma unroll
            for (int i = 0; i < 32; ++i) v[i] = lg2[tok * 33 + i];
            int e[4]; float tv[4]; unsigned taken = 0u;
#pragma unroll
            for (int k = 0; k < 4; ++k) { int bi = 0; float bv = -INFINITY;
#pragma unroll
                for (int i = 0; i < 32; ++i) { const bool ok = !((taken >> i) & 1u) && (v[i] > bv); bv = ok ? v[i] : bv; bi = ok ? i : bi; }
                e[k] = bi; tv[k] = bv; taken |= 1u << bi; }
            float ex[4], sum = 0.f;
#pragma unroll
            for (int k = 0; k < 4; ++k) { ex[k] = __expf(tv[k] - tv[0]); sum += ex[k]; }
            const float inv = 1.f / sum;
            int cnt = 0; int rank[4];
#pragma unroll
            for (int k = 0; k < 4; ++k) { const int ek = act ? e[k] : -1; const int prev = __shfl(cnt, e[k]); int myrank = 0;
#pragma unroll 1
                for (int ee = 0; ee < 32; ++ee) { const unsigned long long mk = __ballot(ek == ee); if (ek == ee) myrank = __popcll(mk & ((1ull << lane) - 1ull)); if (lane == ee) cnt += __popcll(mk); }
                rank[k] = prev + myrank; }
            int base = 0; if (act && cnt > 0) base = (int)atomicAdd(a.count + lane, (unsigned)cnt);
#pragma unroll
            for (int k = 0; k < 4; ++k) { const int p = __shfl(base, e[k]) + rank[k];
                if (act) { a.top_e[t * 4 + k] = e[k]; a.gates[t * 4 + k] = ex[k] * inv; a.pos[t * 4 + k] = p; } }
        }
        __syncthreads();
    }
}
__device__ __forceinline__ void fill_phase(const unsigned* count, const int* top_e, const int* pos, int* pstart_g, int* tile_e, int* slot_of_pair, const bf16_t* H2, bf16_t* XG,
                                           LAS unsigned char* lds, int tid, int lane, int gw, int ngw) {
    LAS int* ps = (LAS int*)lds;
    if (tid == 0) { int acc = 0; for (int e = 0; e < 32; ++e) { ps[e] = acc; acc += ((int)count[e] + 255) / 256 * 256; } ps[32] = acc; }
    __syncthreads();
    if (blockIdx.x == 0) { if (tid < 33) pstart_g[tid] = ps[tid];
        for (int rt = tid; rt < MAXTILES; rt += 512) { const int row = rt * 256; int e = 0; for (int i = 1; i < 32; ++i) if (row >= ps[i]) e = i; tile_e[rt] = e; } }
    for (int t = gw; t < T_TOK; t += ngw) {
        int slot = 0; if (lane < 4) { slot = ps[top_e[t * 4 + lane]] + pos[t * 4 + lane]; slot_of_pair[t * 4 + lane] = slot; }
        const u32x4 v0 = *(const u32x4*)(H2 + (size_t)t * DM + lane * 8), v1 = *(const u32x4*)(H2 + (size_t)t * DM + 512 + lane * 8);
#pragma unroll
        for (int k = 0; k < 4; ++k) { const int sk = __shfl(slot, k); bf16_t* d = XG + (size_t)sk * DM; *(u32x4*)(d + lane * 8) = v0; *(u32x4*)(d + 512 + lane * 8) = v1; }
    }
}
struct CombArgs { const bf16_t* YP; const int* slot_of_pair; const float* gates; const float* X1; const float* mvB; const float* lg; const float* lb; float* OUT;
                  const float* mvN; bf16_t* HB; const float* Wf; const float* fb; float* FL; };
struct CombTok { int sl[4]; float gk[4]; f32x4 x[4]; u32x2 yp[4][4]; };
__device__ __forceinline__ void comb_idx(const CombArgs& a, int t, CombTok& c) {
#pragma unroll
    for (int k = 0; k < 4; ++k) { c.sl[k] = a.slot_of_pair[t * 4 + k]; c.gk[k] = a.gates[t * 4 + k]; }
}
__device__ __forceinline__ void comb_rows(const CombArgs& a, int t, int lane, CombTok& c) {
#pragma unroll
    for (int j = 0; j < 4; ++j) { const int col = 4 * lane + 256 * j; c.x[j] = *(const f32x4*)(a.X1 + (size_t)t * DM + col);
#pragma unroll
        for (int k = 0; k < 4; ++k) c.yp[j][k] = *(const u32x2*)(a.YP + (size_t)c.sl[k] * DM + col); }
}
__device__ __forceinline__ void comb_compute(const CombArgs& a, int t, int lane, const CombTok& c) {
    const int b = t / SEQ; const float* gB = a.mvB + b * 3072 + 2048;
    f32x4 v[4]; float s = 0.f;
#pragma unroll
    for (int j = 0; j < 4; ++j) { const int col = 4 * lane + 256 * j; f32x4 y = {0.f, 0.f, 0.f, 0.f};
#pragma unroll
        for (int k = 0; k < 4; ++k) { const u32x2 w = c.yp[j][k]; y[0] += c.gk[k] * bflo(w.x); y[1] += c.gk[k] * bfhi(w.x); y[2] += c.gk[k] * bflo(w.y); y[3] += c.gk[k] * bfhi(w.y); }
        const f32x4 g = *(const f32x4*)(gB + col);
        v[j] = DN_ALPHA * c.x[j] + (1.f + g) * y; s += (v[j][0] + v[j][1]) + (v[j][2] + v[j][3]); }
    const float mean = wave_sum(s) * (1.f / DM); float s2 = 0.f;
#pragma unroll
    for (int j = 0; j < 4; ++j) { v[j] = v[j] - mean; s2 += (v[j][0] * v[j][0] + v[j][1] * v[j][1]) + (v[j][2] * v[j][2] + v[j][3] * v[j][3]); }
    const float rstd = 1.f / sqrtf(wave_sum(s2) * (1.f / DM) + LN_EPS);
    float fl[8] = {0.f, 0.f, 0.f, 0.f, 0.f, 0.f, 0.f, 0.f};
#pragma unroll
    for (int j = 0; j < 4; ++j) { const int col = 4 * lane + 256 * j; const f32x4 g = *(const f32x4*)(a.lg + col), bb = *(const f32x4*)(a.lb + col);
        const f32x4 x2 = v[j] * rstd * g + bb; *(f32x4*)(a.OUT + (size_t)t * DM + col) = x2;
        if (a.mvN) { const float* mN = a.mvN + b * 3072; const f32x4 sh = *(const f32x4*)(mN + col), sc = *(const f32x4*)(mN + 1024 + col); const f32x4 h = x2 * (1.f + sc) + sh;
            u32x2 w; w.x = pk2(h[0], h[1]); w.y = pk2(h[2], h[3]); *(u32x2*)(a.HB + (size_t)t * DM + col) = w;
#pragma unroll
            for (int hh = 0; hh < 8; ++hh) { const f32x4 wf = *(const f32x4*)(a.Wf + hh * 1024 + col); fl[hh] += (h[0] * wf[0] + h[1] * wf[1]) + (h[2] * wf[2] + h[3] * wf[3]); } } }
    if (a.mvN) {
        float mine = 0.f;
#pragma unroll
        for (int hh = 0; hh < 8; ++hh) { const float tot = wave_sum(fl[hh]); if (lane == hh) mine = tot; }
        if (lane < 8) { const float x = mine + a.fb[lane]; a.FL[t * 8 + lane] = fminf(x, 0.f) - log1pf(__expf(-fabsf(x))); }
    }
}
__device__ __forceinline__ void combine_phase(const CombArgs& a, int gw, int ngw, int lane) {
    for (int t = gw; t < T_TOK; t += 2 * ngw) { const int t1 = t + ngw;
        CombTok c0, c1; comb_idx(a, t, c0); comb_idx(a, t1, c1); comb_rows(a, t, lane, c0); comb_rows(a, t1, lane, c1);
        comb_compute(a, t, lane, c0); comb_compute(a, t1, lane, c1); }
}
struct S5Par { float ar, ai, bbr[16], bbi[16]; };
__device__ __forceinline__ void s5_params(S5Par& P, int g, int p, const float* lam_re, const float* lam_im, const float* log_dt, const float* b_re, const float* b_im) {
    const float dt = expf(log_dt[g]); const float lre = fminf(lam_re[g * 64 + p], -1e-4f), lim = lam_im[g * 64 + p];
    const float mag = expf(lre * dt); P.ar = mag * cosf(lim * dt); P.ai = mag * sinf(lim * dt);
    const float den = lre * lre + lim * lim, nre = P.ar - 1.f, nim = P.ai;
    const float gre = (nre * lre + nim * lim) / den, gim = (nim * lre - nre * lim) / den;
#pragma unroll
    for (int c = 0; c < 16; ++c) { const float br = b_re[(g * 64 + p) * 16 + c], bi = b_im[(g * 64 + p) * 16 + c]; P.bbr[c] = gre * br - gim * bi; P.bbi[c] = gre * bi + gim * br; }
}
__device__ __forceinline__ void s5_load_u(const bf16_t* Z, size_t t, int g, float (&u)[16]) {
    const u32x4* up = (const u32x4*)(Z + t * ZP + g * 16); const u32x4 w0 = up[0], w1 = up[1];
    u[0] = bflo(w0.x); u[1] = bfhi(w0.x); u[2] = bflo(w0.y); u[3] = bfhi(w0.y); u[4] = bflo(w0.z); u[5] = bfhi(w0.z); u[6] = bflo(w0.w); u[7] = bfhi(w0.w);
    u[8] = bflo(w1.x); u[9] = bfhi(w1.x); u[10] = bflo(w1.y); u[11] = bfhi(w1.y); u[12] = bflo(w1.z); u[13] = bfhi(w1.z); u[14] = bflo(w1.w); u[15] = bfhi(w1.w);
}
__device__ __forceinline__ void s5_u_fetch(const bf16_t* Z, size_t t0, int g, int lane, u32x4& w0, u32x4& w1) {
    const u32x4* up = (const u32x4*)(Z + (t0 + lane) * ZP + g * 16); w0 = up[0]; w1 = up[1];
}
__device__ __forceinline__ void s5_u_store(LAS float* U, int lane, const u32x4& w0, const u32x4& w1) {
    LAS f32x4* d = (LAS f32x4*)(U + lane * 16);
    d[0] = (f32x4){bflo(w0.x), bfhi(w0.x), bflo(w0.y), bfhi(w0.y)}; d[1] = (f32x4){bflo(w0.z), bfhi(w0.z), bflo(w0.w), bfhi(w0.w)};
    d[2] = (f32x4){bflo(w1.x), bfhi(w1.x), bflo(w1.y), bfhi(w1.y)}; d[3] = (f32x4){bflo(w1.z), bfhi(w1.z), bflo(w1.w), bfhi(w1.w)};
}
__device__ __forceinline__ void s5_u_read(const LAS float* U, int j, float (&u)[16]) {
    const LAS f32x4* s = (const LAS f32x4*)(U + j * 16);
#pragma unroll
    for (int q = 0; q < 4; ++q) { const f32x4 v = s[q]; u[4 * q] = v[0]; u[4 * q + 1] = v[1]; u[4 * q + 2] = v[2]; u[4 * q + 3] = v[3]; }
}
__device__ __forceinline__ void s5_pass1(const bf16_t* Z, float* SLOC, int gw, int lane, LAS unsigned char* wlds  , const float* lam_re, const float* lam_im, const float* log_dt, const float* b_re, const float* b_im) {
    const int it0 = gw * 4, bg = it0 >> 7, c0 = it0 & 127, b = bg >> 5, g = bg & 31;
    S5Par P; s5_params(P, g, lane, lam_re, lam_im, log_dt, b_re, b_im);
    LAS float* U = (LAS float*)wlds;
    u32x4 w0, w1; s5_u_fetch(Z, (size_t)b * SEQ + c0 * 64, g, lane, w0, w1);
#pragma unroll 1
    for (int q = 0; q < 4; ++q) { const int c = c0 + q; float xr = 0.f, xi = 0.f;
        s5_u_store(U, lane, w0, w1);
        if (q < 3) s5_u_fetch(Z, (size_t)b * SEQ + (c + 1) * 64, g, lane, w0, w1);
        LDS_WAIT();
#pragma unroll 4
        for (int j = 0; j < 64; ++j) { float u[16]; s5_u_read(U, j, u); float bur = 0.f, bui = 0.f;
#pragma unroll
            for (int cc = 0; cc < 16; ++cc) { bur += P.bbr[cc] * u[cc]; bui += P.bbi[cc] * u[cc]; }
            const float nxr = P.ar * xr - P.ai * xi + bur, nxi = P.ar * xi + P.ai * xr + bui; xr = nxr; xi = nxi; }
        *(f32x2*)(SLOC + ((size_t)(bg * 128 + c) * 64 + lane) * 2) = (f32x2){xr, xi};
        LDS_WAIT(); }
}
__device__ __forceinline__ void s5_pass3(const bf16_t* Z, const float* SLOC, bf16_t* YG, int gw, int lane, LAS unsigned char* wlds  ,
                                         const float* lam_re, const float* lam_im, const float* log_dt, const float* b_re, const float* b_im, const float* c_re, const float* c_im, const float* d_skip) {
    const int it0 = gw * 4, bg = it0 >> 7, c0 = it0 & 127, b = bg >> 5, g = bg & 31;
    S5Par P; s5_params(P, g, lane, lam_re, lam_im, log_dt, b_re, b_im);
    float a64r = P.ar, a64i = P.ai;
#pragma unroll
    for (int i = 0; i < 6; ++i) { const float nr = a64r * a64r - a64i * a64i, ni = 2.f * a64r * a64i; a64r = nr; a64i = ni; }
    const int cc = lane & 15, part = lane >> 4;
    float cre[16], cim[16];
#pragma unroll
    for (int i = 0; i < 16; ++i) { cre[i] = c_re[(g * 16 + cc) * 64 + 16 * part + i]; cim[i] = c_im[(g * 16 + cc) * 64 + 16 * part + i]; }
    const float dsk = d_skip[g * 16 + cc];
    float xr = 0.f, xi = 0.f;
    { float pr = 1.f, pi = 0.f;
#pragma unroll 4
        for (int cp = c0 - 1; cp >= 0; --cp) { const f32x2 s = *(const f32x2*)(SLOC + ((size_t)(bg * 128 + cp) * 64 + lane) * 2);
            xr += pr * s.x - pi * s.y; xi += pr * s.y + pi * s.x; const float nr = pr * a64r - pi * a64i, ni = pr * a64i + pi * a64r; pr = nr; pi = ni; } }
    LAS float* XS = (LAS float*)wlds; LAS bf16_t* YO = (LAS bf16_t*)(wlds + 512); LAS float* U = (LAS float*)(wlds + 2560);
    u32x4 w0, w1; s5_u_fetch(Z, (size_t)b * SEQ + c0 * 64, g, lane, w0, w1);
#pragma unroll 1
    for (int q = 0; q < 4; ++q) { const int c = c0 + q;
        s5_u_store(U, lane, w0, w1);
        if (q < 3) s5_u_fetch(Z, (size_t)b * SEQ + (c + 1) * 64, g, lane, w0, w1);
        LDS_WAIT();
#pragma unroll 2
        for (int j = 0; j < 64; ++j) { float u[16]; s5_u_read(U, j, u); float bur = 0.f, bui = 0.f;
#pragma unroll
            for (int k = 0; k < 16; ++k) { bur += P.bbr[k] * u[k]; bui += P.bbi[k] * u[k]; }
            const float nxr = P.ar * xr - P.ai * xi + bur, nxi = P.ar * xi + P.ai * xr + bui; xr = nxr; xi = nxi;
            XS[lane] = xr; XS[64 + lane] = xi;
            float y = 0.f;
#pragma unroll
            for (int i4 = 0; i4 < 4; ++i4) { const f32x4 a = *(const LAS f32x4*)(XS + 16 * part + 4 * i4), bq = *(const LAS f32x4*)(XS + 64 + 16 * part + 4 * i4);
#pragma unroll
                for (int i = 0; i < 4; ++i) y += cre[4 * i4 + i] * a[i] - cim[4 * i4 + i] * bq[i]; }
            y += __shfl_xor(y, 16); y += __shfl_xor(y, 32);
            y += dsk * U[j * 16 + cc];
            const float z2 = 1.5957691216057308f * (y + 0.044715f * y * y * y);
            const float ge = y * fast_sigmoid(z2);
            if (lane < 16) YO[j * 16 + lane] = (bf16_t)(pk2(ge, 0.f) & 0xffffu);
        }
        LDS_WAIT();
#pragma unroll
        for (int ps = 0; ps < 2; ++ps) { const int tok = (lane >> 1) + 32 * ps, half = lane & 1; const u32x4 v = *(const LAS u32x4*)(YO + tok * 16 + half * 8);
            *(u32x4*)(YG + ((size_t)b * SEQ + c * 64 + tok) * 512 + g * 16 + half * 8) = v; }
        LDS_WAIT();
    }
}
__device__ __forceinline__ void f2_seg_scan(const float* FL, float* F2L, float* SEGT, int item, int lane) {
    const int bh = item >> 4, seg = item & 15, b = bh >> 3, h = bh & 7; const float* src = FL + ((size_t)b * SEQ + seg * 512 + 8 * lane) * 8 + h;
    float v[8];
#pragma unroll
    for (int i = 0; i < 8; ++i) v[i] = src[i * 8];
#pragma unroll
    for (int i = 1; i < 8; ++i) v[i] += v[i - 1];
    float inc = v[7];
#pragma unroll
    for (int o = 1; o < 64; o <<= 1) { const float n = __shfl_up(inc, o); if (lane >= o) inc += n; }
    const float ex = inc - v[7]; float* dst = F2L + (size_t)bh * SEQ + seg * 512 + 8 * lane;
    *(f32x4*)dst = (f32x4){(ex + v[0]) * LOG2E, (ex + v[1]) * LOG2E, (ex + v[2]) * LOG2E, (ex + v[3]) * LOG2E};
    *(f32x4*)(dst + 4) = (f32x4){(ex + v[4]) * LOG2E, (ex + v[5]) * LOG2E, (ex + v[6]) * LOG2E, (ex + v[7]) * LOG2E};
    if (lane == 63) SEGT[bh * 16 + seg] = inc * LOG2E;
}
}
typedef GAS unsigned gu32;
#define XB_TMO      128
#define XB_XCNT(j)  (256  + 64 * (j))
#define XB_XSUB(j)  (1280 + 64 * (j))
#define XB_XGEN(j)  (2304 + 64 * (j))
#define XB_TOP      3328
#define XB_TOPGEN   3392
#define XCD_BAR_WORDS 3456
#define XB_SPIN_CAP (1u << 18)

__device__ __forceinline__ unsigned xb_ld(unsigned* p)              { return __hip_atomic_load(p, __ATOMIC_RELAXED, __HIP_MEMORY_SCOPE_AGENT); }
__device__ __forceinline__ unsigned xb_add(unsigned* p, unsigned v) { return __hip_atomic_fetch_add(p, v, __ATOMIC_RELAXED, __HIP_MEMORY_SCOPE_AGENT); }
__device__ __forceinline__ unsigned xb_xcc_id() { return (unsigned)__builtin_amdgcn_s_getreg((3 << 11) | 20) & 0xFu; }
#define XB_SPIN(cond, bar) do { unsigned _sp = 0; while (cond) { __builtin_amdgcn_s_sleep(1); \
    if ((++_sp & 255u) == 0u) { if (xb_ld(&(bar)[XB_TMO])) break; if (_sp > XB_SPIN_CAP) { atomicAdd(&(bar)[XB_TMO], 1u); break; } } } } while (0)

struct XcdBarrier {
    unsigned* bar; unsigned x;
    volatile LAS unsigned* st;
};

__device__ __forceinline__ XcdBarrier xcd_barrier_post(unsigned* bar, volatile LAS unsigned* st) {
    XcdBarrier b; b.bar = bar; b.x = xb_xcc_id(); b.st = st;
    if (threadIdx.x == 0) (void)xb_add(&bar[XB_XCNT(b.x)], 1u);
    return b;
}
__device__ __forceinline__ void xcd_barrier_complete(unsigned* bar, unsigned x, unsigned& nloc, unsigned& nx) {
    const unsigned G = gridDim.x * gridDim.y * gridDim.z;
    unsigned sum, cnt, mine, sp = 0u;
    for (;;) {
        sum = 0u; cnt = 0u; mine = 0u;
#pragma unroll
        for (unsigned j = 0; j < 16; ++j) { const unsigned c = xb_ld(&bar[XB_XCNT(j)]); sum += c; cnt += (c > 0u) ? 1u : 0u; mine = (j == x) ? c : mine; }
        if (sum == G) break;
        __builtin_amdgcn_s_sleep(1);
        if ((++sp & 255u) == 0u) { if (xb_ld(&bar[XB_TMO])) break; if (sp > XB_SPIN_CAP) { atomicAdd(&bar[XB_TMO], 1u); break; } }
    }
    nloc = mine > 0u ? mine : 1u; nx = cnt > 0u ? cnt : 1u;
}

__device__ __forceinline__ void xcd_barrier(const XcdBarrier& b) {
    asm volatile("s_waitcnt vmcnt(0)" ::: "memory");
    __syncthreads();
    if (threadIdx.x == 0) {
        unsigned* bar = b.bar;
        __builtin_amdgcn_s_waitcnt(0);
        unsigned nloc = b.st[0], nx = b.st[1];
        if (nloc == 0u) { xcd_barrier_complete(bar, b.x, nloc, nx); b.st[0] = nloc; b.st[1] = nx; }
        const unsigned old = xb_add(&bar[XB_XSUB(b.x)], 1u);
        const unsigned gen = old / nloc;
        if (old + 1u == (gen + 1u) * nloc) {
            __builtin_amdgcn_fence(__ATOMIC_RELEASE, "agent");
            asm volatile("s_waitcnt vmcnt(0)" ::: "memory");
            const unsigned og = xb_add(&bar[XB_TOP], 1u);
            const unsigned tg = og / nx;
            if (og + 1u == (tg + 1u) * nx) xb_add(&bar[XB_TOPGEN], 1u);
            else XB_SPIN(xb_ld(&bar[XB_TOPGEN]) == tg, bar);
            __builtin_amdgcn_fence(__ATOMIC_ACQUIRE, "agent");
            xb_add(&bar[XB_XGEN(b.x)], 1u);
            asm volatile("s_waitcnt vmcnt(0)" ::: "memory");
        } else {
            XB_SPIN(xb_ld(&bar[XB_XGEN(b.x)]) == gen, bar);
            __builtin_amdgcn_fence(__ATOMIC_ACQUIRE, "agent");
            asm volatile("s_waitcnt vmcnt(0)" ::: "memory");
        }
    }
    __syncthreads();
}
namespace cg = cooperative_groups;
constexpr size_t MiB = 1u << 20;
constexpr size_t WS_CTL = 0, CTL_BYTES = 1 * MiB;
constexpr size_t WS_MODV = 1 * MiB, WS_WF = 1 * MiB + 512 * 1024, WS_WRT = 1 * MiB + 768 * 1024;
constexpr size_t WS_WIN0 = 2 * MiB, WS_WOUT0 = 6 * MiB, WS_WIN1 = 8 * MiB, WS_WOUT1 = 12 * MiB, WS_WGLU = 14 * MiB, WS_INTS = 15 * MiB;
constexpr size_t WS_WGU = 16 * MiB, WS_WDN = 272 * MiB, WS_HB = 400 * MiB, WS_Z = 432 * MiB, WS_CAT = 496 * MiB, WS_Y = 528 * MiB, WS_X1 = 592 * MiB, WS_X2 = 656 * MiB, WS_H2 = 720 * MiB;
constexpr size_t WS_XG = 752 * MiB, WS_ACT = 896 * MiB, WS_ROUTE = 1040 * MiB, WS_FL = 1042 * MiB, WS_F2 = 1042 * MiB + 512 * 1024, WS_SLOC = 1044 * MiB, WS_YG = 1048 * MiB, WS_END = 1064 * MiB;
constexpr size_t WS_STAMP = 15 * MiB + 65536;
constexpr int CW_BAR = 4096;
constexpr int MISC_OFF = 131072 + 512;
constexpr int CW_COUNT = 8192, CW_KMAX = 8320, CW_FOXQ = 8400;
constexpr int LDS_BYTES = 147456;
constexpr int S5_LDS_OFF = 102400;
static_assert(att::L_END <= S5_LDS_OFF && S5_LDS_OFF + 8 * 2560 <= 131072, "LDS map");


struct Params { const float* in[30]; float* out; unsigned char* ws; };
#define KAS __attribute__((address_space(4)))
#define PH_BEGIN \
    const KAS Params* kp = (const KAS Params*)__builtin_amdgcn_kernarg_segment_ptr(); asm volatile("" : "+s"(kp)); \
    int tid = threadIdx.x; asm volatile("" : "+v"(tid)); const int lane = tid & 63; const int wid = __builtin_amdgcn_readfirstlane(tid >> 6); \
    int bx = blockIdx.x; asm volatile("" : "+s"(bx)); const int gw = bx * 8 + wid; constexpr int ngw = 2048, G = 256; (void)lane; (void)gw; (void)ngw; (void)G;
#define GSYNC_CG() cg::this_grid().sync()
#ifdef PROBE
#define STAMP(k) do { if (blockIdx.x == 0 && threadIdx.x == 0) { const KAS Params* kq = (const KAS Params*)__builtin_amdgcn_kernarg_segment_ptr(); ((unsigned long long*)(kq->ws + WS_STAMP))[k] = __builtin_amdgcn_s_memrealtime(); } } while (0)
#else
#define STAMP(k) do {} while (0)
#endif
#define GSYNC() do { PH_BEGIN XcdBarrier b_; b_.bar = (unsigned*)(ctl + CW_BAR); b_.x = xb_xcc_id(); b_.st = (volatile LAS unsigned*)(lds + MISC_OFF); xcd_barrier(b_); } while (0)
#define IN(i) (kp->in[i])
#define WSP(T, off) ((T*)(kp->ws + (off)))
#define x_in IN(0)
#define cvec IN(1)
#define mod_w IN(2)
#define mod_b IN(3)
#define ln_g IN(4)
#define ln_b IN(5)
#define even_w_in IN(6)
#define pool_w IN(7)
#define pool_scale IN(8)
#define rel_bias IN(9)
#define even_w_out IN(10)
#define odd_w_in IN(11)
#define forget_b IN(12)
#define lam_re IN(13)
#define lam_im IN(14)
#define log_dt IN(15)
#define b_re IN(16)
#define b_im IN(17)
#define c_re IN(18)
#define c_im IN(19)
#define d_skip IN(20)
#define glu_w IN(21)
#define glu_b IN(22)
#define odd_w_out IN(23)
#define router_w IN(24)
#define router_b IN(25)
#define exp_w_gu IN(26)
#define exp_b_gu IN(27)
#define exp_w_down IN(28)
#define exp_b_down IN(29)
#define ctl WSP(unsigned, WS_CTL)
#define MODV WSP(float, WS_MODV)
#define WF WSP(float, WS_WF)
#define WRT WSP(bf16_t, WS_WRT)
#define W_IN0 WSP(bf16_t, WS_WIN0)
#define W_OUT0 WSP(bf16_t, WS_WOUT0)
#define W_IN1 WSP(bf16_t, WS_WIN1)
#define W_OUT1 WSP(bf16_t, WS_WOUT1)
#define W_GLU WSP(bf16_t, WS_WGLU)
#define PSTART WSP(int, WS_INTS)
#define TILE_E (PSTART + 64)
#define W_GU WSP(bf16_t, WS_WGU)
#define W_DN WSP(bf16_t, WS_WDN)
#define HB WSP(bf16_t, WS_HB)
#define Z WSP(bf16_t, WS_Z)
#define CAT WSP(bf16_t, WS_CAT)
#define Y WSP(float, WS_Y)
#define X1 WSP(float, WS_X1)
#define X2 WSP(float, WS_X2)
#define H2 WSP(bf16_t, WS_H2)
#define XG WSP(bf16_t, WS_XG)
#define YP WSP(bf16_t, WS_XG)
#define ACT WSP(bf16_t, WS_ACT)
#define TOP_E WSP(int, WS_ROUTE)
#define GATES WSP(float, WS_ROUTE + 256 * 1024)
#define POS WSP(int, WS_ROUTE + 512 * 1024)
#define SLOT WSP(int, WS_ROUTE + 768 * 1024)
#define FL WSP(float, WS_FL)
#define F2 WSP(float, WS_F2)
#define SEGT WSP(float, WS_INTS + 8192)
#define SLOC WSP(float, WS_SLOC)
#define YG WSP(bf16_t, WS_YG)

template <int LAYER> __device__ __forceinline__ void layer_body(LAS unsigned char* lds) {
    { PH_BEGIN
      pg8::Gemm g{HB, LAYER ? W_IN1 : W_IN0, T_TOK, 2048, 1024}; pg8::StaticOrder S; S.init(T_TOK, 2048, G, bx); epi::EpiZ E{Z, ZP, 512, 1024, QSCALE};
      pg8::gemm_phase<epi::EpiZ, pg8::StaticOrder, true, true>(lds, g, S, E, tid); }
    GSYNC(); STAMP(LAYER ? 11 : 3);
    if (LAYER == 0) {
        { PH_BEGIN
          for (int t = gw; t < T_TOK; t += ngw) thin::pool_row(Z, t, CAT, lane); }
        { PH_BEGIN
          for (int ui = bx; ui < 512; ui += G) { const int bh = ui & 15, qb = ui >> 4, b = bh >> 3, h = bh & 7;
              if (tid < 257) ((LAS float*)(lds + att::L_TAB))[tid] = rel_bias[h * 257 + tid] * LOG2E;
              att::attn_unit<0>(b, h, qb, (4 * qb - 8 < 0) ? 0 : 4 * qb - 8, Z, CAT, nullptr, nullptr, (LAS char*)lds, tid); } }
    } else {
        { PH_BEGIN
          thin::s5_pass1(Z, SLOC, gw, lane, lds + wid * 4096, lam_re, lam_im, log_dt, b_re, b_im); }
        { PH_BEGIN
          if (gw < 256) thin::f2_seg_scan(FL, F2, SEGT, gw, lane); }
        { PH_BEGIN
          if (gw < 256) { const int bh = gw >> 4, seg = gw & 15, b = bh >> 3, h = bh & 7; float mx = 0.f;
#pragma unroll 2
              for (int i = 0; i < 8; ++i) { const bf16_t* kp_ = Z + ((size_t)b * SEQ + seg * 512 + i * 64 + lane) * ZP + 1024 + h * 64; float n2 = 0.f;
#pragma unroll
                  for (int c = 0; c < 8; ++c) { const u32x4 w = *(const u32x4*)(kp_ + 8 * c); const float f0 = bflo(w.x), f1 = bfhi(w.x), f2 = bflo(w.y), f3 = bfhi(w.y), f4 = bflo(w.z), f5 = bfhi(w.z), f6 = bflo(w.w), f7 = bfhi(w.w);
                      n2 += (f0 * f0 + f1 * f1) + (f2 * f2 + f3 * f3) + (f4 * f4 + f5 * f5) + (f6 * f6 + f7 * f7); }
                  mx = fmaxf(mx, n2); }
#pragma unroll
              for (int o = 1; o < 64; o <<= 1) mx = fmaxf(mx, __shfl_xor(mx, o));
              if (lane == 0) atomicMax(ctl + CW_KMAX + bh, __float_as_uint(mx)); } }
        GSYNC(); STAMP(12);
        { PH_BEGIN
          thin::s5_pass3(Z, SLOC, YG, gw, lane, lds + wid * 6656, lam_re, lam_im, log_dt, b_re, b_im, c_re, c_im, d_skip); }
        { PH_BEGIN
          LAS int* qs_ = (LAS int*)(lds + MISC_OFF + 64);
          LAS float* segoff = (LAS float*)(lds + MISC_OFF + 128);
          const int r32 = lane & 31, hi = lane >> 5;
          for (;;) {
              asm volatile("" : "+v"(tid));
              if (tid == 0) qs_[0] = (int)atomicAdd(ctl + CW_FOXQ, 1u);
              __syncthreads();
              const int ui = qs_[0]; if (ui >= 512) break;
              const int qb = 31 - (ui >> 4), bh = ui & 15, b = bh >> 3, h = bh & 7, q0 = qb * 256;
              { const bf16_t* Qw = Z + ((size_t)b * SEQ + q0 + wid * 32 + r32) * ZP + 512 + h * 64 + hi * 8; float n2 = 0.f;
#pragma unroll
                for (int d0 = 0; d0 < 4; ++d0) { const u32x4 w = *(const u32x4*)(Qw + d0 * 16); const float f0 = bflo(w.x), f1 = bfhi(w.x), f2 = bflo(w.y), f3 = bfhi(w.y), f4 = bflo(w.z), f5 = bfhi(w.z), f6 = bflo(w.w), f7 = bfhi(w.w);
                    n2 += (f0 * f0 + f1 * f1) + (f2 * f2 + f3 * f3) + (f4 * f4 + f5 * f5) + (f6 * f6 + f7 * f7); }
                n2 += __shfl_xor(n2, 32);
#pragma unroll
                for (int o = 1; o < 32; o <<= 1) n2 = fmaxf(n2, __shfl_xor(n2, o));
                if (lane == 0) qs_[2 + wid] = (int)__float_as_uint(n2); if (tid == 0) qs_[1] = 4 * qb;
                if (tid < 16) { float acc = 0.f; for (int i = 0; i < tid; ++i) acc += SEGT[bh * 16 + i]; segoff[tid] = acc; } }
              __syncthreads();
              { float qn2 = 0.f;
#pragma unroll
                for (int w = 0; w < 8; ++w) qn2 = fmaxf(qn2, __uint_as_float((unsigned)qs_[2 + w]));
                const float kn2 = __uint_as_float(ctl[CW_KMAX + bh]); const float L = 40.0f + 2.0f * sqrtf(qn2 * kn2) * 1.001f + 0.01f;
                const float* F2bh = F2 + (size_t)bh * SEQ; const float f0 = F2bh[q0] + segoff[q0 >> 9];
                if (tid < 4 * qb) { const int s_ = 64 * tid + 63; const float fs = F2bh[s_] + segoff[s_ >> 9]; if (f0 - fs >= -L) __hip_atomic_fetch_min(&qs_[1], tid, __ATOMIC_RELAXED, __HIP_MEMORY_SCOPE_WORKGROUP); } }
              __syncthreads();
              const int jlo = qs_[1];
              att::attn_unit<1>(b, h, qb, jlo, Z, CAT, F2 + (size_t)bh * SEQ, segoff, (LAS char*)lds, tid);
          } }
        GSYNC(); STAMP(13);
        { PH_BEGIN
          pg8::Gemm g{YG, W_GLU, T_TOK, 512, 512}; pg8::StaticOrder S; S.init(T_TOK, 512, G, bx); epi::EpiGlu E{CAT, YG, glu_b};
          pg8::gemm_phase<epi::EpiGlu, pg8::StaticOrder, true, true>(lds, g, S, E, tid); }
    }
    GSYNC(); STAMP(LAYER ? 14 : 4);
    { PH_BEGIN
      pg8::Gemm g{CAT, LAYER ? W_OUT1 : W_OUT0, T_TOK, 1024, 1024}; pg8::StaticOrder S; S.init(T_TOK, 1024, G, bx); epi::EpiF32 E{Y, 1024};
      pg8::gemm_phase<epi::EpiF32, pg8::StaticOrder, true, true>(lds, g, S, E, tid); }
    GSYNC(); STAMP(LAYER ? 15 : 5);
    { PH_BEGIN
      thin::LnrArgs a{LAYER ? X2 : x_in, Y, MODV + (LAYER * 2 + 0) * 2 * 3072, MODV + (LAYER * 2 + 1) * 2 * 3072, ln_g + (LAYER * 2 + 0) * 1024, ln_b + (LAYER * 2 + 0) * 1024, X1, H2,
                      WRT + LAYER * 32768, router_b + LAYER * 32, ctl + CW_COUNT + LAYER * 64, TOP_E, GATES, POS};
      thin::lnr_phase(a, lds, tid, lane, wid); }
    GSYNC(); STAMP(LAYER ? 16 : 6);
    { PH_BEGIN
      thin::fill_phase(ctl + CW_COUNT + LAYER * 64, TOP_E, POS, PSTART, TILE_E, SLOT, H2, XG, lds, tid, lane, gw, ngw); }
    GSYNC(); STAMP(LAYER ? 17 : 7);
    { PH_BEGIN
      const int R = PSTART[32] >> 8;
      pg8::Gemm g{XG, W_GU + (size_t)LAYER * 32 * 2097152, MAXROWS, 2048, 1024}; epi::MoeOrder S{R, 8, bx, TILE_E, (size_t)2097152 * 2}; epi::EpiSwiglu E{ACT, exp_b_gu + (size_t)LAYER * 32 * 2048};
      pg8::gemm_phase<epi::EpiSwiglu, epi::MoeOrder, true, true>(lds, g, S, E, tid); }
    GSYNC(); STAMP(LAYER ? 18 : 8);
    { PH_BEGIN
      const int R = PSTART[32] >> 8;
      pg8::Gemm g{ACT, W_DN + (size_t)LAYER * 32 * 1048576, MAXROWS, 1024, 1024}; epi::MoeOrder S{R, 4, bx, TILE_E, (size_t)1048576 * 2}; epi::EpiBiasBf16 E{YP, exp_b_down + (size_t)LAYER * 32 * 1024};
      pg8::gemm_phase<epi::EpiBiasBf16, epi::MoeOrder, true, true>(lds, g, S, E, tid); }
    GSYNC(); STAMP(LAYER ? 19 : 9);
    { PH_BEGIN
      thin::CombArgs a{YP, SLOT, GATES, X1, MODV + (LAYER * 2 + 1) * 2 * 3072, ln_g + (LAYER * 2 + 1) * 1024, ln_b + (LAYER * 2 + 1) * 1024, LAYER ? kp->out : X2,
                       LAYER ? nullptr : MODV + 2 * 2 * 3072, HB, WF, forget_b, FL};
      thin::combine_phase(a, gw, ngw, lane); }
}

__global__ void __launch_bounds__(512, 2) mega_fwd(Params p_unused) {
    extern __shared__ __attribute__((aligned(16))) unsigned char lds_raw[];
    LAS unsigned char* lds = (LAS unsigned char*)lds_raw;
    if (threadIdx.x < 16) ((LAS unsigned*)(lds + MISC_OFF))[threadIdx.x] = 0u;
    __syncthreads();
    { PH_BEGIN (void)xcd_barrier_post((unsigned*)(ctl + CW_BAR), (volatile LAS unsigned*)(lds + MISC_OFF)); }
    STAMP(0);
    { PH_BEGIN
      thin::ada_mod(cvec, mod_w, mod_b, MODV, lds, tid, lane, wid); }
    __syncthreads();
    { PH_BEGIN
      LAS float* scr = (LAS float*)(lds + wid * 8448);
      for (int it = gw; it < 3968; it += ngw) { int r = it; float v[32]; thin::TrItem d;
        if (r >= 2944) { thin::fold_item(pool_w, pool_scale, even_w_out, r - 2944, W_OUT0, lane); continue; }
        if (r < 1024) d = thin::tr_matrix_desc(even_w_in, 2048, 2048, r, W_IN0, 1024, 0);
        else if (r < 1280) d = thin::tr_matrix_desc(even_w_out + 512 * 1024, 1024, 1024, r - 1024, W_OUT0, 1024, 512);
        else if (r < 2304) d = thin::tr_matrix_desc(odd_w_in, 2056, 2048, r - 1280, W_IN1, 1024, 0);
        else if (r < 2816) d = thin::tr_matrix_desc(odd_w_out, 1024, 1024, r - 2304, W_OUT1, 1024, 0);
        else d = thin::tr_matrix_desc(glu_w, 512, 512, r - 2816, W_GLU, 512, 0);
        thin::tr_load(d, lane, v); thin::tr_store(d, lane, v, scr); }
      for (int idx = gw * 64 + lane; idx < 8192; idx += ngw * 64) WF[idx] = odd_w_in[(size_t)(idx & 1023) * 2056 + 2048 + (idx >> 10)];
      for (int idx = gw * 64 + lane; idx < 65536; idx += ngw * 64) { const int layer = idx >> 15, r = idx & 32767, e = r >> 10, k = r & 1023; WRT[idx] = (bf16_t)(pk2(router_w[layer * 32768 + k * 32 + e], 0.f) & 0xffffu); } }
    GSYNC_CG(); STAMP(1);
    { PH_BEGIN
      for (int t = gw; t < T_TOK; t += ngw) thin::mod_row(x_in + (size_t)t * DM, MODV + (0 * 2 + t / SEQ) * 3072, HB + (size_t)t * DM, lane); }
    { PH_BEGIN
      LAS float* scr = (LAS float*)(lds + wid * 8448);
      auto desc = [&](int it) -> thin::TrItem {
          if (it < 65536) { const int le = it >> 10, r = it & 1023; return thin::tr_gu_desc(exp_w_gu + (size_t)le * 2097152, r, W_GU + (size_t)le * 2097152); }
          const int r0 = it - 65536, le = r0 >> 9, r = r0 & 511; return thin::tr_matrix_desc(exp_w_down + (size_t)le * 1048576, 1024, 1024, r, W_DN + (size_t)le * 1048576, 1024, 0); };
      float va[32], vb[32]; thin::TrItem da = desc(gw), db;
      thin::tr_load(da, lane, va);
      for (int it = gw; it < 98304; it += 2 * ngw) {
          db = desc(it + ngw); thin::tr_load(db, lane, vb);
          thin::tr_store(da, lane, va, scr);
          if (it + 2 * ngw < 98304) { da = desc(it + 2 * ngw); thin::tr_load(da, lane, va); }
          thin::tr_store(db, lane, vb, scr); } }
    GSYNC(); STAMP(2);
    layer_body<0>(lds);
    GSYNC(); STAMP(10);
    layer_body<1>(lds);
#ifdef PROBE
    STAMP(20);
    if (blockIdx.x == 0 && threadIdx.x == 0) {
        const KAS Params* kq = (const KAS Params*)__builtin_amdgcn_kernarg_segment_ptr(); const volatile unsigned long long* stp = (const volatile unsigned long long*)(kq->ws + WS_STAMP);
        const unsigned long long dt = (stp[PROBE_B] - stp[PROBE_A]) * PROBE_K; const unsigned long long t0 = __builtin_amdgcn_s_memrealtime();
        while (__builtin_amdgcn_s_memrealtime() - t0 < dt) __builtin_amdgcn_s_sleep(16);
    }
#endif
}
#undef PH_BEGIN
#undef GSYNC
#undef STAMP
#undef GSYNC_CG
#undef IN
#undef WSP
#undef x_in
#undef cvec
#undef mod_w
#undef mod_b
#undef ln_g
#undef ln_b
#undef even_w_in
#undef pool_w
#undef pool_scale
#undef rel_bias
#undef even_w_out
#undef odd_w_in
#undef forget_b
#undef lam_re
#undef lam_im
#undef log_dt
#undef b_re
#undef b_im
#undef c_re
#undef c_im
#undef d_skip
#undef glu_w
#undef glu_b
#undef odd_w_out
#undef router_w
#undef router_b
#undef exp_w_gu
#undef exp_b_gu
#undef exp_w_down
#undef exp_b_down
#undef ctl
#undef MODV
#undef WF
#undef WRT
#undef W_IN0
#undef W_OUT0
#undef W_IN1
#undef W_OUT1
#undef W_GLU
#undef PSTART
#undef TILE_E
#undef W_GU
#undef W_DN
#undef HB
#undef Z
#undef CAT
#undef Y
#undef X1
#undef X2
#undef H2
#undef XG
#undef YP
#undef ACT
#undef TOP_E
#undef GATES
#undef POS
#undef SLOT
#undef FL
#undef F2
#undef SEGT
#undef SLOC
#undef YG
static bool launch_mega(void* const* d_in, void* d_out, void* d_ws, size_t ws_size, hipStream_t stream) {
    static int grid = 0;
    if (grid == 0) {
        int dev = 0, cus = 0, per_cu = 0;
        if (ws_size < WS_END) { fprintf(stderr, "kernel_launch: workspace too small (%zu < %zu)\n", ws_size, (size_t)WS_END); grid = -1; return false; }
        if (hipGetDevice(&dev) != hipSuccess || hipDeviceGetAttribute(&cus, hipDeviceAttributeMultiprocessorCount, dev) != hipSuccess) { grid = -1; return false; }
        if (hipFuncSetAttribute((const void*)mega_fwd, hipFuncAttributeMaxDynamicSharedMemorySize, LDS_BYTES) != hipSuccess) { fprintf(stderr, "kernel_launch: hipFuncSetAttribute failed\n"); grid = -1; return false; }
        if (hipOccupancyMaxActiveBlocksPerMultiprocessor(&per_cu, (const void*)mega_fwd, 512, LDS_BYTES) != hipSuccess || per_cu < 1) { fprintf(stderr, "kernel_launch: occupancy query says %d blocks per CU\n", per_cu); grid = -1; return false; }
        (void)hipGetLastError();
        grid = cus;
        if (grid != 256) { fprintf(stderr, "kernel_launch: built for a 256-CU device, found %d CUs\n", cus); grid = -1; return false; }
    }
    if (grid < 0) return false;
    (void)hipMemsetAsync((char*)d_ws + WS_CTL, 0, CTL_BYTES, stream);
    Params p{};
    for (int i = 0; i < 30; ++i) p.in[i] = (const float*)d_in[i];
    p.out = (float*)d_out; p.ws = (unsigned char*)d_ws;
    void* args[] = {&p};
    hipError_t e = hipLaunchCooperativeKernel((const void*)mega_fwd, dim3(grid), dim3(512), args, LDS_BYTES, stream);
    if (e != hipSuccess) { fprintf(stderr, "cooperative launch failed: %s (grid %d)\n", hipGetErrorString(e), grid); return false; }
    return true;
}
extern "C" void kernel_launch(void* const* d_in, const int* in_sizes, int n_in, void* d_out, int out_size, void* d_ws, size_t ws_size, hipStream_t stream) {
    launch_mega(d_in, d_out, d_ws, ws_size, stream);
}
```
